# Optimizing an MI355X kernel written in HIP

```python
import jax, jax.numpy as jnp
from jax import lax
import numpy as np

D_MODEL = 1024
BATCH = 8
SEQ = 2048
DEPTH = 2

FOURIER_GROUPS = 4
FOURIER_GROUP_DIM = D_MODEL // 8
FOURIER_WIDTH = FOURIER_GROUPS * FOURIER_GROUP_DIM
GMLP_GROUPS = 4
GMLP_GROUP_DIM = D_MODEL // 8
GMLP_WIDTH = GMLP_GROUPS * GMLP_GROUP_DIM
CHUNK = 128
N_BRANCH = 2
D_IN = FOURIER_WIDTH + 2 * GMLP_WIDTH + N_BRANCH * D_MODEL
D_FF_DENSE = 11 * D_MODEL // 4
N_EXPERTS = 8
TOP_K = 2
D_FF_EXPERT = 7 * D_MODEL // 2
N_DENSE = (DEPTH + 1) // 2
N_MOE = DEPTH // 2
RMS_EPS = 1e-6
LN_EPS = 1e-5

kernel_name = 'hybrid_fourier_gmlp_moe_encoder'


def rms_norm(x, g):
    xf = x.astype(jnp.float32)
    y = xf * lax.rsqrt(jnp.mean(xf * xf, axis=-1, keepdims=True) + RMS_EPS)
    return (y * g.astype(jnp.float32)).astype(x.dtype)


def layer_norm(x, g, b):
    xf = x.astype(jnp.float32)
    mu = jnp.mean(xf, axis=-1, keepdims=True)
    xc = xf - mu
    var = jnp.mean(xc * xc, axis=-1, keepdims=True)
    y = xc * lax.rsqrt(var + LN_EPS) * g.astype(jnp.float32) + b.astype(jnp.float32)
    return y.astype(x.dtype)


def fourier_mix(a):
    af = a.astype(jnp.float32)
    return jnp.fft.fft2(af, axes=(1, 3), norm='ortho').real.astype(a.dtype)


def spatial_gating(u, v, w_s, b_s, ln_g, ln_b):
    B, S, _ = v.shape
    v = layer_norm(v, ln_g, ln_b)
    v = v.reshape(B, S // CHUNK, CHUNK, GMLP_GROUPS, GMLP_GROUP_DIM)
    sv = jnp.einsum('gpq,bcqgd->bcpgd', w_s, v) + jnp.transpose(b_s)[:, :, None]
    return u * sv.reshape(B, S, GMLP_WIDTH)


def token_mixer(h, w_in, w_fourier, w_gmlp, w_out, w_s, b_s, ln_g, ln_b):
    B, S, D = h.shape
    z = jnp.einsum('bsd,de->bse', h, w_in)
    c1 = FOURIER_WIDTH
    c2 = c1 + GMLP_WIDTH
    c3 = c2 + GMLP_WIDTH
    za, zu, zv, zg = z[..., :c1], z[..., c1:c2], z[..., c2:c3], z[..., c3:]
    fa = fourier_mix(za.reshape(B, S, FOURIER_GROUPS, FOURIER_GROUP_DIM)).reshape(B, S, FOURIER_WIDTH)
    ya = jnp.einsum('bsf,fd->bsd', fa, w_fourier)
    sg = spatial_gating(jax.nn.gelu(zu, approximate=False), jax.nn.gelu(zv, approximate=False),
                        w_s, b_s, ln_g, ln_b)
    yb = jnp.einsum('bsf,fd->bsd', sg, w_gmlp)
    g = jax.nn.sigmoid(zg.reshape(B, S, N_BRANCH, D))
    m = g[:, :, 0, :] * ya + g[:, :, 1, :] * yb
    return jnp.einsum('bsd,de->bse', m, w_out)


def swiglu(h, w1, w3, w2):
    a = jnp.einsum('...d,df->...f', h, w1)
    b = jnp.einsum('...d,df->...f', h, w3)
    return jnp.einsum('...f,fd->...d', jax.nn.silu(a) * b, w2)


def moe_swiglu(h, router_w, router_b, w1, w3, w2):
    B, S, D = h.shape
    t = h.reshape(B * S, D)
    logits = jnp.einsum('td,de->te', t, router_w).astype(jnp.float32) + router_b.astype(jnp.float32)
    top_vals, top_idx = lax.top_k(logits, TOP_K)
    top_w = jax.nn.softmax(top_vals, axis=-1)
    gate = jnp.sum(jax.nn.one_hot(top_idx, N_EXPERTS, dtype=jnp.float32) * top_w[..., None], axis=1)
    gate = gate.astype(t.dtype)
    out = jnp.zeros_like(t)
    for e in range(N_EXPERTS):
        out = out + gate[:, e:e + 1] * swiglu(t, w1[e], w3[e], w2[e])
    return out.reshape(B, S, D)


def setup_inputs(seed: int = 0) -> dict:
    key = jax.random.key(seed)
    ks = jax.random.split(key, 24)
    f32 = jnp.float32
    nrm = lambda k, shape, fan_in: jax.random.normal(k, shape, f32) * (fan_in ** -0.5)
    gain = lambda k, shape: 1.0 + 0.02 * jax.random.normal(k, shape, f32)
    small = lambda k, shape, s: s * jax.random.normal(k, shape, f32)
    return {
        'x': jax.random.normal(ks[0], (BATCH, SEQ, D_MODEL), f32),
        'pre_mix_g': gain(ks[1], (DEPTH, D_MODEL)),
        'post_mix_g': gain(ks[2], (DEPTH, D_MODEL)),
        'w_in': nrm(ks[3], (DEPTH, D_MODEL, D_IN), D_MODEL),
        'w_fourier': nrm(ks[4], (DEPTH, FOURIER_WIDTH, D_MODEL), FOURIER_WIDTH),
        'w_gmlp': nrm(ks[5], (DEPTH, GMLP_WIDTH, D_MODEL), GMLP_WIDTH),
        'w_out': nrm(ks[6], (DEPTH, D_MODEL, D_MODEL), D_MODEL),
        'w_spatial': nrm(ks[7], (DEPTH, GMLP_GROUPS, CHUNK, CHUNK), CHUNK),
        'b_spatial': gain(ks[8], (DEPTH, GMLP_GROUPS, CHUNK)),
        'gmlp_ln_g': gain(ks[9], (DEPTH, GMLP_WIDTH)),
        'gmlp_ln_b': small(ks[10], (DEPTH, GMLP_WIDTH), 0.02),
        'pre_ffn_g': gain(ks[11], (DEPTH, D_MODEL)),
        'post_ffn_g': gain(ks[12], (DEPTH, D_MODEL)),
        'ffn_w1': nrm(ks[13], (N_DENSE, D_MODEL, D_FF_DENSE), D_MODEL),
        'ffn_w3': nrm(ks[14], (N_DENSE, D_MODEL, D_FF_DENSE), D_MODEL),
        'ffn_w2': nrm(ks[15], (N_DENSE, D_FF_DENSE, D_MODEL), D_FF_DENSE),
        'router_w': nrm(ks[16], (N_MOE, D_MODEL, N_EXPERTS), D_MODEL),
        'router_b': small(ks[17], (N_MOE, N_EXPERTS), 0.01),
        'moe_w1': nrm(ks[18], (N_MOE, N_EXPERTS, D_MODEL, D_FF_EXPERT), D_MODEL),
        'moe_w3': nrm(ks[19], (N_MOE, N_EXPERTS, D_MODEL, D_FF_EXPERT), D_MODEL),
        'moe_w2': nrm(ks[20], (N_MOE, N_EXPERTS, D_FF_EXPERT, D_MODEL), D_FF_EXPERT),
    }


def reference(x, pre_mix_g, post_mix_g, w_in, w_fourier, w_gmlp, w_out, w_spatial, b_spatial,
              gmlp_ln_g, gmlp_ln_b, pre_ffn_g, post_ffn_g, ffn_w1, ffn_w3, ffn_w2,
              router_w, router_b, moe_w1, moe_w3, moe_w2):
    for l in range(DEPTH):
        h = rms_norm(x, pre_mix_g[l])
        y = token_mixer(h, w_in[l], w_fourier[l], w_gmlp[l], w_out[l], w_spatial[l], b_spatial[l],
                        gmlp_ln_g[l], gmlp_ln_b[l])
        x = x + rms_norm(y, post_mix_g[l])
        h = rms_norm(x, pre_ffn_g[l])
        if l % 2 == 0:
            i = l // 2
            y = swiglu(h, ffn_w1[i], ffn_w3[i], ffn_w2[i])
        else:
            i = l // 2
            y = moe_swiglu(h, router_w[i], router_b[i], moe_w1[i], moe_w3[i], moe_w2[i])
        x = x + rms_norm(y, post_ffn_g[l])
    return x
```

```cpp
#include <hip/hip_runtime.h>
#include <cstdio>
#include <cstdint>
#include <math.h>
#define MEGA_DEBUG 0

namespace pg8 {
#define PG8_LAS __attribute__((address_space(3)))
typedef unsigned short bf16_t;
typedef short bf16x8 __attribute__((ext_vector_type(8)));
typedef float f32x4 __attribute__((ext_vector_type(4)));
typedef unsigned u32x4 __attribute__((ext_vector_type(4)));
constexpr int BM = 256, BK = 64, HALF = 128, HTB = HALF * BK * 2  , STAGE_BYTES = 8 * HTB, NXCD = 8, WGM = 8;

__host__ __device__ __forceinline__ int lds_byte(int r, int c) { const int st = (r >> 4) * 2 + (c >> 5), rr = r & 15, cc = c & 31, ob = rr * 64 + cc * 2; return st * 1024 + (ob ^ (((ob >> 9) & 1) << 5)); }
__host__ __device__ __forceinline__ void stage_rc(int b, int& R, int& C) { const int st = b / 1024, sb = b % 1024, swz = sb ^ (((sb >> 9) & 1) << 5); R = (st >> 1) * 16 + swz / 64; C = (st & 1) * 32 + (swz % 64) / 2; }
__host__ __device__ __forceinline__ int perm32(int rho) { const int n = rho >> 4, i = rho & 15; return 8 * (i >> 2) + 4 * n + (i & 3); }

struct Unit { const char* a; const char* b; int r0, c0, tag; };

__device__ __forceinline__ bool order_xy(long L, int nM, int nN, int& pm, int& pn) {
    const int nwg = nM * nN; if (L >= nwg) return false;
    int wgid = (int)L; { const int q = nwg / NXCD, r = nwg % NXCD, xcd = wgid % NXCD, off = wgid / NXCD; wgid = (xcd < r ? xcd * (q + 1) : r * (q + 1) + (xcd - r) * q) + off; }
    const int nig = WGM * nN, gid = wgid / nig, fm = gid * WGM, gsz = (nM - fm) < WGM ? (nM - fm) : WGM;
    pm = fm + ((wgid % nig) % gsz); pn = (wgid % nig) / gsz; return true;
}
struct SchedPlain {
    const char* A; const char* B; size_t ta, tb; int nM, nN, G, c;
    __device__ __forceinline__ bool next(int i, Unit& u) const { int pm, pn; if (!order_xy((long)i * G + c, nM, nN, pm, pn)) return false;
        u.a = A + (size_t)pm * ta; u.b = B + (size_t)pn * tb; u.r0 = pm; u.c0 = pn; u.tag = 0; return true; }
    __device__ __forceinline__ void a_ready(const Unit&) const {}
    __device__ __forceinline__ void done(const Unit&) const {}
};
struct SchedInProj {
    const char* XN; const char* W; size_t t; int G, c;
    __device__ __forceinline__ bool next(int i, Unit& u) const { int pm, pn; if (!order_xy((long)i * G + c, 64, 16, pm, pn)) return false;
        if (pn < 4) { u.a = W + (size_t)pn * t; u.b = XN + (size_t)pm * t; u.r0 = pn; u.c0 = pm; u.tag = 1; }
        else        { u.a = XN + (size_t)pm * t; u.b = W + (size_t)pn * t; u.r0 = pm; u.c0 = pn; u.tag = 0; }
        return true; }
    __device__ __forceinline__ void a_ready(const Unit&) const {}
    __device__ __forceinline__ void done(const Unit&) const {}
};
struct SchedMoe {
    const char* A; size_t ta; const char* W; size_t we, tb; const PG8_LAS int* texp; int t0, nM, nN, G, c, n2;
    __device__ __forceinline__ bool next(int i, Unit& u) const { int pm, pn; const int n1 = G - n2;
        constexpr int SKIP = 4;
        const long L = (c >= n2) ? ((i < SKIP) ? (long)i * n1 + (c - n2) : (long)SKIP * n1 + (long)(i - SKIP) * G + c) : (long)SKIP * n1 + (long)i * G + c;
        if (!order_xy(L, nM, nN, pm, pn)) return false;
        const int e = __builtin_amdgcn_readfirstlane(texp[t0 + pm]);
        u.a = A + (size_t)pm * ta; u.b = W + (size_t)e * we + (size_t)pn * tb; u.r0 = pm; u.c0 = pn; u.tag = 0; return true; }
    __device__ __forceinline__ void a_ready(const Unit&) const {}
    __device__ __forceinline__ void done(const Unit&) const {}
};
struct SchedMerge {
    const char* A0; const char* B0; const char* A1; const char* B1; size_t t; int G, c;
    __device__ __forceinline__ bool next(int i, Unit& u) const { int pm, pn; if (i >= 2 || !order_xy((long)c, 64, 4, pm, pn)) return false;
        u.a = (i ? A1 : A0) + (size_t)pm * t; u.b = (i ? B1 : B0) + (size_t)pn * t; u.r0 = pm; u.c0 = pn; u.tag = i; return true; }
    __device__ __forceinline__ void a_ready(const Unit&) const {}
    __device__ __forceinline__ void done(const Unit&) const {}
};
typedef float f32x2_t __attribute__((ext_vector_type(2)));
typedef __bf16 bf16x2_t __attribute__((ext_vector_type(2)));
__device__ __forceinline__ unsigned cvt_pk_bf16(float lo, float hi) { const f32x2_t v = {lo, hi}; const bf16x2_t b = __builtin_convertvector(v, bf16x2_t); return __builtin_bit_cast(unsigned, b); }
typedef float f32x2 __attribute__((ext_vector_type(2)));
__device__ __forceinline__ f32x2 gelu_pk(f32x2 v) {
    const f32x2 av = __builtin_elementwise_abs(v), d = av * 0.2316418882f + 1.0f;
    f32x2 t; t.x = __builtin_amdgcn_rcpf(d.x); t.y = __builtin_amdgcn_rcpf(d.y);
    f32x2 q = t * 0.5307027145f + (-0.7265760135f); q = q * t + 0.7107068705f; q = q * t + (-0.142248368f); q = q * t + 0.127414796f; q = q * t;
    const f32x2 s = (v * v) * (-0.72134752044f);
    f32x2 e; e.x = __builtin_amdgcn_exp2f(s.x); e.y = __builtin_amdgcn_exp2f(s.y);
    const f32x2 m = v * (q * e), r = v - m;
    f32x2 o; o.x = v.x < 0.f ? m.x : r.x; o.y = v.y < 0.f ? m.y : r.y; return o;
}

typedef int i32x8 __attribute__((ext_vector_type(8)));
typedef int i32x4v __attribute__((ext_vector_type(4)));
__device__ __forceinline__ i32x8 cat8(bf16x8 lo, bf16x8 hi) { return __builtin_shufflevector(__builtin_bit_cast(i32x4v, lo), __builtin_bit_cast(i32x4v, hi), 0, 1, 2, 3, 4, 5, 6, 7); }
__device__ __forceinline__ unsigned pack4_fp8(float a, float b, float c, float d) {
    a = __builtin_amdgcn_fmed3f(a, -448.f, 448.f); b = __builtin_amdgcn_fmed3f(b, -448.f, 448.f); c = __builtin_amdgcn_fmed3f(c, -448.f, 448.f); d = __builtin_amdgcn_fmed3f(d, -448.f, 448.f);
    int w = 0; w = __builtin_amdgcn_cvt_pk_fp8_f32(a, b, w, false); w = __builtin_amdgcn_cvt_pk_fp8_f32(c, d, w, true); return (unsigned)w; }
#ifndef EPI_WT
#define EPI_WT 0
#endif
typedef unsigned u32x2s __attribute__((ext_vector_type(2)));
struct WtBase { __amdgpu_buffer_rsrc_t r; const char* base; };
__device__ __forceinline__ WtBase wt_base() {
    typedef const __attribute__((address_space(4))) unsigned long long* KP;
    KP kp = (KP)__builtin_amdgcn_kernarg_segment_ptr(); asm volatile("" : "+s"(kp));
    char* ws = (char*)kp[22];
    WtBase b; b.r = __builtin_amdgcn_make_buffer_rsrc(ws, 0, 0x7fffffff, 0x00020000); b.base = ws; return b; }
__device__ __forceinline__ void st16(const WtBase& b, void* p, u32x4 w) {
#if EPI_WT
    __builtin_amdgcn_raw_buffer_store_b128(w, b.r, (int)((const char*)p - b.base), 0, 16);
#else
    *(u32x4*)p = w;
#endif
}
__device__ __forceinline__ void st8(const WtBase& b, void* p, u32x2s w) {
#if EPI_WT
    __builtin_amdgcn_raw_buffer_store_b64(w, b.r, (int)((const char*)p - b.base), 0, 16);
#else
    *(u32x2s*)p = w;
#endif
}
__device__ __forceinline__ float sigm_fast(float x) { return __builtin_amdgcn_rcpf(1.0f + __builtin_amdgcn_exp2f(-1.44269504f * x)); }
__device__ __forceinline__ f32x4 act4(f32x4 v, int act) {
    if (act == 1) { const f32x2 a = gelu_pk((f32x2){v[0], v[1]}), b = gelu_pk((f32x2){v[2], v[3]}); return (f32x4){a.x, a.y, b.x, b.y}; }
    if (act == 2) return (f32x4){sigm_fast(v[0]), sigm_fast(v[1]), sigm_fast(v[2]), sigm_fast(v[3])};
    return v;
}
__device__ __forceinline__ u32x4 pack8(f32x4 v0, f32x4 v1) { u32x4 w; w.x = cvt_pk_bf16(v0[0], v0[1]); w.y = cvt_pk_bf16(v0[2], v0[3]); w.z = cvt_pk_bf16(v1[0], v1[1]); w.w = cvt_pk_bf16(v1[2], v1[3]); return w; }
__device__ __forceinline__ void unpack8(u32x4 w, f32x4& v0, f32x4& v1) {
    v0 = (f32x4){__uint_as_float(w.x << 16), __uint_as_float(w.x & 0xffff0000u), __uint_as_float(w.y << 16), __uint_as_float(w.y & 0xffff0000u)};
    v1 = (f32x4){__uint_as_float(w.z << 16), __uint_as_float(w.z & 0xffff0000u), __uint_as_float(w.w << 16), __uint_as_float(w.w & 0xffff0000u)}; }
template <int ACT> __device__ __forceinline__ void store_tile_bf16(const f32x4 (&acc)[2][2][4][2], bf16_t* base, size_t ldc) {
    const WtBase wb = wt_base();
#pragma unroll
    for (int ai = 0; ai < 2; ++ai)
#pragma unroll
        for (int m = 0; m < 4; ++m) { bf16_t* rowp = base + (size_t)(ai * HALF + m * 16) * ldc;
#pragma unroll
            for (int bj = 0; bj < 2; ++bj) st16(wb, rowp + bj * HALF, pack8(act4(acc[ai][bj][m][0], ACT), act4(acc[ai][bj][m][1], ACT))); }
}
struct EpiInProj {
    static constexpr bool PERM = true, AFTER_DRAIN = false;
    bf16_t *PQT, *GU, *GV, *G0, *G1;
    __device__ __forceinline__ void operator()(const f32x4 (&acc)[2][2][4][2], const Unit& u, int wr, int wc, int fr, int fq) const {
        if (u.tag) { const int tok0 = u.c0 * BM, b = tok0 >> 11, s0 = tok0 & 2047;
            store_tile_bf16<0>(acc, PQT + ((size_t)b * 1024 + u.r0 * BM + wr * 64 + fr) * 2048 + s0 + wc * 32 + 8 * fq, 2048); }
        else { const int wt = u.c0; const size_t row = (size_t)u.r0 * BM + wr * 64 + fr; const int col = wc * 32 + 8 * fq;
            if (wt < 8) { bf16_t* dst = (wt < 6 ? GU : GV) + row * 512 + (wt & 1) * BM + col; store_tile_bf16<1>(acc, dst, 512); }
            else { bf16_t* dst = (wt < 12 ? G0 : G1) + row * 1024 + (wt & 3) * BM + col;
#ifdef DBG_RAWGATE
                store_tile_bf16<0>(acc, dst, 1024);
#else
                store_tile_bf16<2>(acc, dst, 1024);
#endif
            } }
    }
};
struct EpiDft {
    static constexpr bool PERM = true, AFTER_DRAIN = false;
    bf16_t* FA;
    __device__ __forceinline__ void operator()(const f32x4 (&acc)[2][2][4][2], const Unit& u, int wr, int wc, int fr, int fq) const {
        const WtBase wb = wt_base();
        const int k0 = u.r0 * BM + wr * 64 + fr;
#pragma unroll
        for (int bj = 0; bj < 2; ++bj) { const int n0 = u.c0 * BM + bj * HALF, b = n0 >> 9, ch = (n0 & 511) + wc * 32 + 8 * fq;
#pragma unroll
            for (int ai = 0; ai < 2; ++ai)
#pragma unroll
                for (int m = 0; m < 4; ++m) st16(wb, FA + ((size_t)b * 2048 + k0 + ai * HALF + m * 16) * 512 + ch, pack8(acc[ai][bj][m][0], acc[ai][bj][m][1])); }
    }
};
struct EpiGate2 {
    static constexpr bool PERM = true, AFTER_DRAIN = false;
    const bf16_t* G0; const bf16_t* G1; bf16_t* Mm;
    __device__ __forceinline__ void operator()(f32x4 (&acc)[2][2][4][2], const Unit& u, int wr, int wc, int fr, int fq) const {
        const size_t off0 = ((size_t)u.r0 * BM + wr * 64 + fr) * 1024 + u.c0 * BM + wc * 32 + 8 * fq;
        const bf16_t* Gt = u.tag ? G1 : G0;
        u32x4 t[2][4][2];
#pragma unroll
        for (int ai = 0; ai < 2; ++ai)
#pragma unroll
            for (int m = 0; m < 4; ++m)
#pragma unroll
                for (int bj = 0; bj < 2; ++bj) t[ai][m][bj] = *(const u32x4*)(Gt + off0 + (size_t)(ai * HALF + m * 16) * 1024 + bj * HALF);
#pragma unroll
        for (int ai = 0; ai < 2; ++ai)
#pragma unroll
            for (int m = 0; m < 4; ++m)
#pragma unroll
                for (int bj = 0; bj < 2; ++bj) { f32x4 g0, g1; unpack8(t[ai][m][bj], g0, g1); acc[ai][bj][m][0] *= g0; acc[ai][bj][m][1] *= g1; }
        if (u.tag) {
#pragma unroll
            for (int ai = 0; ai < 2; ++ai)
#pragma unroll
                for (int m = 0; m < 4; ++m)
#pragma unroll
                    for (int bj = 0; bj < 2; ++bj) t[ai][m][bj] = *(const u32x4*)(Mm + off0 + (size_t)(ai * HALF + m * 16) * 1024 + bj * HALF);
#pragma unroll
            for (int ai = 0; ai < 2; ++ai)
#pragma unroll
                for (int m = 0; m < 4; ++m)
#pragma unroll
                    for (int bj = 0; bj < 2; ++bj) { f32x4 p0, p1; unpack8(t[ai][m][bj], p0, p1); acc[ai][bj][m][0] += p0; acc[ai][bj][m][1] += p1; }
        }
        asm volatile("" ::: "memory");
#pragma unroll
        for (int ai = 0; ai < 2; ++ai)
#pragma unroll
            for (int m = 0; m < 4; ++m)
#pragma unroll
                for (int bj = 0; bj < 2; ++bj) *(u32x4*)(Mm + off0 + (size_t)(ai * HALF + m * 16) * 1024 + bj * HALF) = pack8(acc[ai][bj][m][0], acc[ai][bj][m][1]);
    }
};
struct EpiF32 {
    static constexpr bool PERM = false, AFTER_DRAIN = false;
    float* C; int ldc;
    __device__ __forceinline__ void operator()(const f32x4 (&acc)[2][2][4][2], const Unit& u, int wr, int wc, int fr, int fq) const {
        const int row0 = u.r0 * BM + wr * 64 + fr, col0 = u.c0 * BM + wc * 32 + 4 * fq;
#pragma unroll
        for (int ai = 0; ai < 2; ++ai)
#pragma unroll
            for (int m = 0; m < 4; ++m) { float* rowp = C + (size_t)(row0 + ai * HALF + m * 16) * ldc + col0;
#pragma unroll
                for (int bj = 0; bj < 2; ++bj)
#pragma unroll
                    for (int n = 0; n < 2; ++n) *(f32x4*)(rowp + bj * HALF + n * 16) = acc[ai][bj][m][n]; }
    }
};
struct EpiBf16Plain {
    static constexpr bool PERM = true, AFTER_DRAIN = false;
    bf16_t* O; int ldc;
    __device__ __forceinline__ void operator()(const f32x4 (&acc)[2][2][4][2], const Unit& u, int wr, int wc, int fr, int fq) const {
        store_tile_bf16<0>(acc, O + ((size_t)u.r0 * BM + wr * 64 + fr) * ldc + u.c0 * BM + wc * 32 + 8 * fq, ldc); }
};
struct EpiSwiglu {
    static constexpr bool PERM = true, AFTER_DRAIN = false;
    bf16_t* H; int ldc;
    __device__ __forceinline__ void operator()(const f32x4 (&acc)[2][2][4][2], const Unit& u, int wr, int wc, int fr, int fq) const {
        const WtBase wb = wt_base();
        bf16_t* base = H + ((size_t)u.r0 * BM + wr * 64 + fr) * ldc + u.c0 * HALF + wc * 32 + 8 * fq;
#pragma unroll
        for (int ai = 0; ai < 2; ++ai)
#pragma unroll
            for (int m = 0; m < 4; ++m) { f32x4 v[2];
#pragma unroll
                for (int n = 0; n < 2; ++n) { const f32x4 a = acc[ai][0][m][n], b = acc[ai][1][m][n];
                    v[n] = (f32x4){a[0] * sigm_fast(a[0]) * b[0], a[1] * sigm_fast(a[1]) * b[1], a[2] * sigm_fast(a[2]) * b[2], a[3] * sigm_fast(a[3]) * b[3]}; }
                st16(wb, base + (size_t)(ai * HALF + m * 16) * ldc, pack8(v[0], v[1])); }
    }
};

typedef unsigned u32x2 __attribute__((ext_vector_type(2)));
struct EpiSwiglu8 {
    static constexpr bool PERM = true, AFTER_DRAIN = false;
    unsigned char* H; int ldc; float sin, sout;
    __device__ __forceinline__ void operator()(const f32x4 (&acc)[2][2][4][2], const Unit& u, int wr, int wc, int fr, int fq) const {
        const WtBase wb = wt_base();
        unsigned char* base = H + ((size_t)u.r0 * BM + wr * 64 + fr) * ldc + u.c0 * HALF + wc * 32 + 8 * fq;
        const float c1 = -1.44269504f * sin, is2 = 1.0f / (sin * sin * sout);
#pragma unroll
        for (int ai = 0; ai < 2; ++ai)
#pragma unroll
            for (int m = 0; m < 4; ++m) { u32x2 w;
#pragma unroll
                for (int n = 0; n < 2; ++n) { const f32x4 a = acc[ai][0][m][n], b = acc[ai][1][m][n]; float v[4];
#pragma unroll
                    for (int i = 0; i < 4; ++i) v[i] = (a[i] * b[i]) * __builtin_amdgcn_rcpf(__builtin_fmaf(__builtin_amdgcn_exp2f(a[i] * c1), is2, is2));
                    const unsigned pw = pack4_fp8(v[0], v[1], v[2], v[3]); if (n == 0) w.x = pw; else w.y = pw; }
                { u32x2s w2; w2.x = w.x; w2.y = w.y; st8(wb, base + (size_t)(ai * HALF + m * 16) * ldc, w2); } }
    }
};
struct EpiBf16Scaled {
    static constexpr bool PERM = true, AFTER_DRAIN = false;
    bf16_t* O; int ldc; float s;
    __device__ __forceinline__ void operator()(const f32x4 (&acc)[2][2][4][2], const Unit& u, int wr, int wc, int fr, int fq) const {
        const WtBase wb = wt_base();
        bf16_t* base = O + ((size_t)u.r0 * BM + wr * 64 + fr) * ldc + u.c0 * BM + wc * 32 + 8 * fq;
#pragma unroll
        for (int ai = 0; ai < 2; ++ai)
#pragma unroll
            for (int m = 0; m < 4; ++m) { bf16_t* rowp = base + (size_t)(ai * HALF + m * 16) * ldc;
#pragma unroll
                for (int bj = 0; bj < 2; ++bj) __builtin_nontemporal_store(pack8(acc[ai][bj][m][0] * s, acc[ai][bj][m][1] * s), (u32x4*)(rowp + bj * HALF)); }
    }
};
template <class Epi, class Sched, bool ALIGN_EPI = false, bool SP2 = false, bool FP8 = false>
__device__ __forceinline__ void gemm_phase(PG8_LAS unsigned char* lds, const int K, const Sched& S, const Epi& E, const int xflags = 0) {
    int tid_ = threadIdx.x; asm volatile("" : "+v"(tid_));
    const int tid = tid_, wid = __builtin_amdgcn_readfirstlane(tid >> 6), lane = tid & 63, wr = wid >> 2, wc = wid & 3, fr = lane & 15, fq = lane >> 4;
    int nt_ = K / BK; asm volatile("" : "+s"(nt_)); const int nt = nt_;
    unsigned voffA[2], voffB[2];
#pragma unroll
    for (int i = 0; i < 2; ++i) { int R, C; stage_rc(tid * 16 + i * 8192, R, C); const int Rb = Epi::PERM ? ((R & ~31) + perm32(R & 31)) : R;
        voffA[i] = (unsigned)(R * K + C) * 2u; voffB[i] = (unsigned)(Rb * K + C) * 2u; }
    const size_t kstep = (size_t)(BK * 2);
    const size_t hstep = (size_t)HALF * K * 2;
    const unsigned ldsw = (unsigned)wid * 1024u;
    const int aoff = lds_byte(wr * 64 + fr, fq * 8), boff = lds_byte(wc * 32 + fr, fq * 8);
#define PG8_SA(b, h) (((b) * 2 + (h)) * HTB)
#define PG8_SB(b, h) ((4 + (b) * 2 + (h)) * HTB)
#define PG8_STAGE(bufoff, gbase, voff) do { _Pragma("unroll") for (int _i = 0; _i < 2; ++_i) \
        __builtin_amdgcn_global_load_lds((const unsigned*)((const char*)(gbase) + (voff)[_i]), (PG8_LAS unsigned*)(lds + (bufoff) + ldsw + _i * 8192), 16, 0, 0); } while (0)
#define PG8_LDA(dst, b, h) do { if constexpr (FP8) { _Pragma("unroll") for (int m = 0; m < 4; ++m) dst##8[m] = cat8(*(const PG8_LAS bf16x8*)(lds + PG8_SA(b, h) + aoff + m * 2048), *(const PG8_LAS bf16x8*)(lds + PG8_SA(b, h) + aoff + m * 2048 + 1024)); } \
    else { _Pragma("unroll") for (int m = 0; m < 4; ++m) _Pragma("unroll") for (int k = 0; k < 2; ++k) dst[m][k] = *(const PG8_LAS bf16x8*)(lds + PG8_SA(b, h) + aoff + m * 2048 + k * 1024); } } while (0)
#define PG8_LDB(dst, b, h) do { if constexpr (FP8) { _Pragma("unroll") for (int n = 0; n < 2; ++n) dst##8[n] = cat8(*(const PG8_LAS bf16x8*)(lds + PG8_SB(b, h) + boff + n * 2048), *(const PG8_LAS bf16x8*)(lds + PG8_SB(b, h) + boff + n * 2048 + 1024)); } \
    else { _Pragma("unroll") for (int n = 0; n < 2; ++n) _Pragma("unroll") for (int k = 0; k < 2; ++k) dst[n][k] = *(const PG8_LAS bf16x8*)(lds + PG8_SB(b, h) + boff + n * 2048 + k * 1024); } } while (0)
#define PG8_MMA(ai, bj, At, Bt) do { if constexpr (FP8) __builtin_amdgcn_sched_barrier(0); __builtin_amdgcn_s_setprio(1); _Pragma("unroll") for (int m = 0; m < 4; ++m) _Pragma("unroll") for (int n = 0; n < 2; ++n) { \
        if constexpr (FP8) asm volatile("v_mfma_scale_f32_16x16x128_f8f6f4 %0, %1, %2, %0, %3, %3 op_sel_hi:[0,0,0]" : "+v"(acc[ai][bj][m][n]) : "v"(Bt##8[n]), "v"(At##8[m]), "v"(fp8_one)); \
        else { _Pragma("unroll") for (int k = 0; k < 2; ++k) acc[ai][bj][m][n] = __builtin_amdgcn_mfma_f32_16x16x32_bf16(Bt[n][k], At[m][k], acc[ai][bj][m][n], 0, 0, 0); } } __builtin_amdgcn_s_setprio(0); if constexpr (FP8) __builtin_amdgcn_sched_barrier(0); } while (0)
#define PG8_WAIT_V(n) asm volatile("s_waitcnt vmcnt(" #n ")" ::: "memory")
#define PG8_WAIT_L(n) asm volatile("s_waitcnt lgkmcnt(" #n ")" ::: "memory")
#define PG8_BAR __builtin_amdgcn_s_barrier()
#define PG8_SCHED __builtin_amdgcn_sched_barrier(0)
    Unit cur, nxt; int ui = 0;
    if (!S.next(0, cur)) return;
    f32x4 acc[2][2][4][2];
#pragma unroll
    for (int a = 0; a < 2; ++a)
#pragma unroll
        for (int b = 0; b < 2; ++b)
#pragma unroll
            for (int m = 0; m < 4; ++m)
#pragma unroll
                for (int n = 0; n < 2; ++n) acc[a][b][m][n] = (f32x4){0.f, 0.f, 0.f, 0.f};
    bf16x8 At[4][2], B0[2][2], B1[2][2];
    const int fp8_one = 0x7f7f7f7f;
    i32x8 At8[4], B08[2], B18[2];
    const char* cA = cur.a; const char* cB = cur.b;
    S.a_ready(cur);
    if constexpr (SP2) {
        PG8_STAGE(PG8_SB(0, 0), cB, voffB); PG8_STAGE(PG8_SB(0, 1), cB + hstep, voffB); PG8_STAGE(PG8_SA(0, 0), cA, voffA); PG8_STAGE(PG8_SA(0, 1), cA + hstep, voffA);
        if (wr == 1) PG8_BAR;
        PG8_WAIT_V(2); PG8_BAR;
        PG8_STAGE(PG8_SB(1, 0), cB + kstep, voffB); PG8_STAGE(PG8_SA(1, 0), cA + kstep, voffA); PG8_STAGE(PG8_SB(1, 1), cB + hstep + kstep, voffB);
        PG8_WAIT_V(6); PG8_BAR;
    } else {
        PG8_STAGE(PG8_SB(0, 0), cB, voffB); PG8_STAGE(PG8_SA(0, 0), cA, voffA); PG8_STAGE(PG8_SB(0, 1), cB + hstep, voffB); PG8_STAGE(PG8_SA(0, 1), cA + hstep, voffA);
        if (wr == 1) PG8_BAR;
        PG8_WAIT_V(4); PG8_BAR;
        PG8_STAGE(PG8_SB(1, 0), cB + kstep, voffB); PG8_STAGE(PG8_SA(1, 0), cA + kstep, voffA); PG8_STAGE(PG8_SB(1, 1), cB + hstep + kstep, voffB);
        PG8_WAIT_V(6); PG8_BAR;
    }
    for (;;) {
        const bool has_next = S.next(ui + 1, nxt);
        const char* nA = has_next ? nxt.a : cA; const char* nB = has_next ? nxt.b : cB;
#pragma nounroll
        for (int t = 0; t < nt; t += 2) {
            const bool last = (t == nt - 2);
            const char* a1 = cA + (size_t)(t + 1) * kstep;
            const char* a2 = last ? nA : cA + (size_t)(t + 2) * kstep; const char* b2 = last ? nB : cB + (size_t)(t + 2) * kstep;
            const char* a3 = a2 + kstep; const char* b3 = b2 + kstep;
            if (last && has_next) S.a_ready(nxt);
            if constexpr (SP2) {
            PG8_LDB(B0, 0, 0); PG8_LDB(B1, 0, 1); PG8_SCHED; PG8_LDA(At, 0, 0); PG8_STAGE(PG8_SA(1, 1), a1 + hstep, voffA);
            PG8_WAIT_V(8); PG8_WAIT_L(0); PG8_BAR; PG8_MMA(0, 0, At, B0); PG8_MMA(0, 1, At, B1); PG8_BAR; PG8_SCHED;
            PG8_LDA(At, 0, 1); PG8_STAGE(PG8_SB(0, 0), b2, voffB); PG8_STAGE(PG8_SB(0, 1), b2 + hstep, voffB); PG8_STAGE(PG8_SA(0, 0), a2, voffA);
            PG8_WAIT_V(8); PG8_WAIT_L(0); PG8_BAR; PG8_MMA(1, 0, At, B0); PG8_MMA(1, 1, At, B1); PG8_BAR; PG8_SCHED;
            PG8_LDB(B0, 1, 0); PG8_LDB(B1, 1, 1); PG8_SCHED; PG8_LDA(At, 1, 0); PG8_STAGE(PG8_SA(0, 1), a2 + hstep, voffA);
            PG8_WAIT_V(8); PG8_WAIT_L(0); PG8_BAR; PG8_MMA(0, 0, At, B0); PG8_MMA(0, 1, At, B1); PG8_BAR; PG8_SCHED;
            PG8_LDA(At, 1, 1); PG8_STAGE(PG8_SB(1, 0), b3, voffB); PG8_STAGE(PG8_SB(1, 1), b3 + hstep, voffB); PG8_STAGE(PG8_SA(1, 0), a3, voffA);
            PG8_WAIT_V(8); PG8_WAIT_L(0); PG8_BAR; PG8_MMA(1, 0, At, B0); PG8_MMA(1, 1, At, B1); PG8_BAR; PG8_SCHED;
            } else {
            PG8_LDB(B0, 0, 0); PG8_SCHED; PG8_LDA(At, 0, 0); PG8_STAGE(PG8_SA(1, 1), a1 + hstep, voffA);
            PG8_WAIT_L(8); PG8_BAR; PG8_WAIT_L(0); PG8_MMA(0, 0, At, B0); PG8_BAR; PG8_SCHED;
            PG8_LDB(B1, 0, 1); PG8_STAGE(PG8_SB(0, 0), b2, voffB);
            PG8_BAR; PG8_WAIT_L(0); PG8_MMA(0, 1, At, B1); PG8_BAR;
            PG8_LDA(At, 0, 1); PG8_STAGE(PG8_SA(0, 0), a2, voffA);
            PG8_BAR; PG8_WAIT_L(0); PG8_MMA(1, 0, At, B0); PG8_BAR; PG8_SCHED;
            PG8_STAGE(PG8_SB(0, 1), b2 + hstep, voffB);
            PG8_WAIT_V(6); PG8_BAR; PG8_MMA(1, 1, At, B1); PG8_BAR;
            PG8_LDB(B0, 1, 0); PG8_SCHED; PG8_LDA(At, 1, 0); PG8_STAGE(PG8_SA(0, 1), a2 + hstep, voffA);
            PG8_WAIT_L(8); PG8_BAR; PG8_WAIT_L(0); PG8_MMA(0, 0, At, B0); PG8_BAR; PG8_SCHED;
            PG8_LDB(B1, 1, 1); PG8_STAGE(PG8_SB(1, 0), b3, voffB);
            PG8_BAR; PG8_WAIT_L(0); PG8_MMA(0, 1, At, B1); PG8_BAR;
            PG8_LDA(At, 1, 1); PG8_STAGE(PG8_SA(1, 0), a3, voffA);
            PG8_BAR; PG8_WAIT_L(0); PG8_MMA(1, 0, At, B0); PG8_BAR; PG8_SCHED;
            PG8_STAGE(PG8_SB(1, 1), b3 + hstep, voffB);
            PG8_WAIT_V(6); PG8_BAR; PG8_MMA(1, 1, At, B1); PG8_BAR;
            }
        }
        if constexpr (FP8) asm volatile("s_nop 15\n\ts_nop 15" ::: "memory");
        if constexpr (ALIGN_EPI) { if (wr == 0) PG8_BAR; }
        if constexpr (!Epi::AFTER_DRAIN) { if (!(xflags & 1)) E(acc, cur, wr, wc, fr, fq); S.done(cur); }
        if (!has_next) break;
#pragma unroll
        for (int a = 0; a < 2; ++a)
#pragma unroll
            for (int b = 0; b < 2; ++b)
#pragma unroll
                for (int m = 0; m < 4; ++m)
#pragma unroll
                    for (int n = 0; n < 2; ++n) acc[a][b][m][n] = (f32x4){0.f, 0.f, 0.f, 0.f};
        cur = nxt; cA = nA; cB = nB; ++ui;
        if constexpr (ALIGN_EPI) { if (wr == 1) PG8_BAR; }
    }
    PG8_WAIT_V(0);
    if constexpr (!ALIGN_EPI) { if (wr == 0) PG8_BAR; }
    PG8_BAR;
    if constexpr (Epi::AFTER_DRAIN) { E.fused(acc, cur, wr, wc, fr, fq, lds, wid, lane); S.done(cur); }
#undef PG8_SA
#undef PG8_SB
#undef PG8_STAGE
#undef PG8_LDA
#undef PG8_LDB
#undef PG8_MMA
#undef PG8_WAIT_V
#undef PG8_WAIT_L
#undef PG8_BAR
#undef PG8_SCHED
}

}
constexpr int NWAVES = 8;
constexpr int D = 1024, NB = 8, S = 2048, T = NB * S;
constexpr int DIN = 3584, NIN = 4096;
constexpr int FFD = 2816, FFE = 3584, NE = 8;
constexpr int XG_ROWS = 2 * T + NE * 256, NT_MAX = XG_ROWS / 256;
constexpr int CHUNK_TILES = 64;
constexpr float RMS_EPS = 1e-6f, LN_EPS = 1e-5f;
constexpr size_t MiB = 1u << 20, KiB = 1024;
constexpr size_t WS_CTL = 0, CTL_ZERO_BYTES = 1 * MiB;
constexpr size_t WS_E12 = 1 * MiB, WS_W12 = WS_E12 + 128 * KiB, WS_POS = WS_W12 + 128 * KiB, WS_WGCNT = WS_POS + 128 * KiB, WS_TEXP = WS_WGCNT + 8 * KiB, WS_WSB = WS_E12 + 512 * KiB;
constexpr size_t WS_MW13 = 4 * MiB, WS_MW2 = 60 * MiB;
constexpr size_t WS_WIN = 88 * MiB, WS_WF = 104 * MiB, WS_WG = 106 * MiB, WS_WOUT = 108 * MiB;
constexpr size_t WS_DW13 = 112 * MiB, WS_DW2 = 123 * MiB;
constexpr size_t WS_DFT = 129 * MiB;
constexpr size_t WS_XN = 145 * MiB;
constexpr size_t WS_PQT = 177 * MiB, WS_MM = WS_PQT;
constexpr size_t WS_GU = 209 * MiB, WS_GV = 225 * MiB;
constexpr size_t WS_G0 = 241 * MiB, WS_G1 = 273 * MiB, WS_Y = WS_G0;
constexpr size_t WS_FA = 305 * MiB, WS_SG = 337 * MiB;
constexpr size_t WS_HD = 177 * MiB, WS_YD = 265 * MiB;
constexpr size_t WS_XG = 177 * MiB, WS_HM = 211 * MiB, WS_HM2 = 274 * MiB, WS_YG = 330 * MiB;
constexpr size_t WS_END = 398 * MiB;
constexpr float ACT_SCALE = 16.f, W13_SCALE = 64.f, W2_SCALE = 128.f;
static_assert(WS_HM + (size_t)(NT_MAX - CHUNK_TILES) * 256 * FFE <= WS_HM2 && WS_HM2 + (size_t)CHUNK_TILES * 256 * FFE <= WS_YG && WS_YG + (size_t)XG_ROWS * D * 2 <= WS_END && WS_XG + (size_t)XG_ROWS * D <= WS_HM, "d_ws map");
constexpr int CW_TMO = 0, CW_CODE = 1, CW_NTILES = 16, CW_BAR = 4096;
constexpr int RING_BYTES = 131072;
constexpr int LDS_MISC = 139264, LDS_TEXP = LDS_MISC + 256, LDS_BYTES = 147456;
#define GAS __attribute__((address_space(1)))
#define LAS __attribute__((address_space(3)))
typedef unsigned short bf16;
typedef unsigned v4u __attribute__((ext_vector_type(4)));
typedef unsigned v2u __attribute__((ext_vector_type(2)));
typedef float f32x4 __attribute__((ext_vector_type(4)));
typedef short bf16x8 __attribute__((ext_vector_type(8)));
typedef GAS unsigned gu32;
#define RLX_AGENT __ATOMIC_RELAXED, __HIP_MEMORY_SCOPE_AGENT
#define LDS_WAIT() asm volatile("s_waitcnt lgkmcnt(0)" ::: "memory")
#define VM_WAIT() asm volatile("s_waitcnt vmcnt(0)" ::: "memory")
__device__ __forceinline__ unsigned pk2(float lo, float hi) { return pg8::cvt_pk_bf16(lo, hi); }
__device__ __forceinline__ float bflo(unsigned w) { return __uint_as_float(w << 16); }
__device__ __forceinline__ float bfhi(unsigned w) { return __uint_as_float(w & 0xffff0000u); }
__device__ __forceinline__ float wave_sum(float v) {
#pragma unroll
    for (int o = 1; o < 64; o <<= 1) v += __shfl_xor(v, o);
    return v;
}
#define XB_TMO      128
#define XB_XCNT(j)  (256  + 64 * (j))
#define XB_XSUB(j)  (1280 + 64 * (j))
#define XB_XGEN(j)  (2304 + 64 * (j))
#define XB_TOP      3328
#define XB_TOPGEN   3392
#define XCD_BAR_WORDS 3456
#define XB_SPIN_CAP (1u << 18)

__device__ __forceinline__ unsigned xb_ld(unsigned* p)              { return __hip_atomic_load(p, __ATOMIC_RELAXED, __HIP_MEMORY_SCOPE_AGENT); }
__device__ __forceinline__ unsigned xb_add(unsigned* p, unsigned v) { return __hip_atomic_fetch_add(p, v, __ATOMIC_RELAXED, __HIP_MEMORY_SCOPE_AGENT); }
__device__ __forceinline__ unsigned xb_xcc_id() { return (unsigned)__builtin_amdgcn_s_getreg((3 << 11) | 20) & 0xFu; }
#define XB_SPIN(cond, bar) do { unsigned _sp = 0; while (cond) { __builtin_amdgcn_s_sleep(1); \
    if ((++_sp & 255u) == 0u) { if (xb_ld(&(bar)[XB_TMO])) break; if (_sp > XB_SPIN_CAP) { atomicAdd(&(bar)[XB_TMO], 1u); break; } } } } while (0)

struct XcdBarrier {
    unsigned* bar; unsigned x;
    volatile LAS unsigned* st;
};

__device__ __forceinline__ XcdBarrier xcd_barrier_post(unsigned* bar, volatile LAS unsigned* st) {
    XcdBarrier b; b.bar = bar; b.x = xb_xcc_id(); b.st = st;
    if (threadIdx.x == 0) (void)xb_add(&bar[XB_XCNT(b.x)], 1u);
    return b;
}
__device__ __forceinline__ void xcd_barrier_complete(unsigned* bar, unsigned x, unsigned& nloc, unsigned& nx) {
    const unsigned G = gridDim.x * gridDim.y * gridDim.z;
    unsigned sum, cnt, mine, sp = 0u;
    for (;;) {
        sum = 0u; cnt = 0u; mine = 0u;
#pragma unroll
        for (unsigned j = 0; j < 16; ++j) { const unsigned c = xb_ld(&bar[XB_XCNT(j)]); sum += c; cnt += (c > 0u) ? 1u : 0u; mine = (j == x) ? c : mine; }
        if (sum == G) break;
        __builtin_amdgcn_s_sleep(1);
        if ((++sp & 255u) == 0u) { if (xb_ld(&bar[XB_TMO])) break; if (sp > XB_SPIN_CAP) { atomicAdd(&bar[XB_TMO], 1u); break; } }
    }
    nloc = mine > 0u ? mine : 1u; nx = cnt > 0u ? cnt : 1u;
}

__device__ __forceinline__ void xcd_barrier(const XcdBarrier& b) {
    asm volatile("s_waitcnt vmcnt(0)" ::: "memory");
    __syncthreads();
    if (threadIdx.x == 0) {
        unsigned* bar = b.bar;
        __builtin_amdgcn_s_waitcnt(0);
        unsigned nloc = b.st[0], nx = b.st[1];
        if (nloc == 0u) { xcd_barrier_complete(bar, b.x, nloc, nx); b.st[0] = nloc; b.st[1] = nx; }
        const unsigned old = xb_add(&bar[XB_XSUB(b.x)], 1u);
        const unsigned gen = old / nloc;
        if (old + 1u == (gen + 1u) * nloc) {
            __builtin_amdgcn_fence(__ATOMIC_RELEASE, "agent");
            asm volatile("s_waitcnt vmcnt(0)" ::: "memory");
            const unsigned og = xb_add(&bar[XB_TOP], 1u);
            const unsigned tg = og / nx;
            if (og + 1u == (tg + 1u) * nx) xb_add(&bar[XB_TOPGEN], 1u);
            else XB_SPIN(xb_ld(&bar[XB_TOPGEN]) == tg, bar);
            __builtin_amdgcn_fence(__ATOMIC_ACQUIRE, "agent");
            xb_add(&bar[XB_XGEN(b.x)], 1u);
            asm volatile("s_waitcnt vmcnt(0)" ::: "memory");
        } else {
            XB_SPIN(xb_ld(&bar[XB_XGEN(b.x)]) == gen, bar);
            __builtin_amdgcn_fence(__ATOMIC_ACQUIRE, "agent");
            asm volatile("s_waitcnt vmcnt(0)" ::: "memory");
        }
    }
    __syncthreads();
}

__device__ __forceinline__ void tr_item(const float* __restrict__ W, int ldw, bf16* __restrict__ WT, int ldt, int k0, int n0, int drow0, LAS unsigned* scr, int lane) {
    const int n4 = (lane & 15) * 4, kq = lane >> 4;
    const float* src = W + (size_t)(k0 + 2 * kq) * ldw + n0 + n4;
    f32x4 v0[16], v1[16];
#pragma unroll
    for (int it = 0; it < 16; ++it) { const float* p = src + (size_t)(it * 8) * ldw; v0[it] = __builtin_nontemporal_load((const f32x4*)p); v1[it] = __builtin_nontemporal_load((const f32x4*)(p + ldw)); }
#pragma unroll
    for (int it = 0; it < 16; ++it) { const int kp = it * 4 + kq;
#pragma unroll
        for (int i = 0; i < 4; ++i) scr[(n4 + i) * 66 + kp] = pk2(v0[it][i], v1[it][i]); }
    LDS_WAIT(); asm volatile("" ::: "memory");
    const int c = lane & 15;
#pragma unroll
    for (int r = 0; r < 16; ++r) { const int j = (lane >> 4) + 4 * r; const LAS v2u* s = (const LAS v2u*)(scr + j * 66 + 4 * c);
        const v2u a = s[0], b = s[1]; v4u o; o.x = a.x; o.y = a.y; o.z = b.x; o.w = b.y;
        __builtin_nontemporal_store(o, (GAS v4u*)(WT + (size_t)(drow0 + j) * ldt + k0 + 8 * c)); }
    LDS_WAIT(); asm volatile("" ::: "memory");
}
__device__ __forceinline__ void tr_item8(const float* __restrict__ W, int ldw, unsigned char* __restrict__ WT, int ldt, int k0, int n0, int drow0, float scale, LAS unsigned* scr, int lane) {
    const int n4 = (lane & 15) * 4, kq = lane >> 4;
    f32x4 v[2][4][4];
#pragma unroll
    for (int hh = 0; hh < 2; ++hh)
#pragma unroll
        for (int it = 0; it < 4; ++it)
#pragma unroll
            for (int rr = 0; rr < 4; ++rr) v[hh][it][rr] = __builtin_nontemporal_load((const f32x4*)(W + (size_t)(k0 + hh * 64 + (it * 4 + kq) * 4 + rr) * ldw + n0 + n4));
#pragma unroll
    for (int hh = 0; hh < 2; ++hh)
#pragma unroll
        for (int it = 0; it < 4; ++it) { const int kw = hh * 16 + it * 4 + kq;
#pragma unroll
            for (int i = 0; i < 4; ++i) scr[(n4 + i) * 34 + kw] = pg8::pack4_fp8(v[hh][it][0][i] * scale, v[hh][it][1][i] * scale, v[hh][it][2][i] * scale, v[hh][it][3][i] * scale); }
    LDS_WAIT(); asm volatile("" ::: "memory");
    const int c = lane & 7;
#pragma unroll
    for (int r = 0; r < 8; ++r) { const int j = (lane >> 3) + 8 * r; const LAS v2u* sp = (const LAS v2u*)(scr + j * 34 + 4 * c);
        const v2u a = sp[0], b = sp[1]; v4u o; o.x = a.x; o.y = a.y; o.z = b.x; o.w = b.y;
        __builtin_nontemporal_store(o, (GAS v4u*)(WT + (size_t)(drow0 + j) * ldt + k0 + 16 * c)); }
    LDS_WAIT(); asm volatile("" ::: "memory");
}
struct Args { const float* in[21]; float* out; unsigned char* ws; int ph_lo, ph_hi, flags, pad; };
typedef const __attribute__((address_space(4))) Args* ArgsP;
__device__ __forceinline__ ArgsP kargs() { ArgsP p = (ArgsP)__builtin_amdgcn_kernarg_segment_ptr(); asm volatile("" : "+s"(p)); return p; }

template <int WHICH>
__device__ __forceinline__ void convert_weights(ArgsP io, LAS unsigned char* lds, int lane, int wave, int gw, int NGW) {
    unsigned char* ws = io->ws;
    const float* w_in = io->in[3];
    LAS unsigned* scr = (LAS unsigned*)(lds + wave * 16896);
    constexpr int IT_IN = 8 * 48, IT_F = 4 * 16, IT_O = 8 * 16, IT_D13 = 8 * 44, IT_D2 = 22 * 16, IT_M13 = 8 * 56, IT_M2 = 28 * 16;
    constexpr int NITEMS = WHICH == 1 ? NE * (2 * IT_M13 + IT_M2) : (WHICH == 3 ? 2 * IT_D13 + IT_D2 : IT_IN + 2 * IT_F + IT_O);
    for (int it = gw; it < NITEMS; it += NGW) {
        int r = it; const float* W = nullptr; bf16* WT = nullptr; int ldw = 0, ldt = 0, nnb = 1, mode = 0, roff = 0; float f8 = 0.f; bool found = false;
#define TR_ENTRY8(W_, K_, N_, ldw_, WT_, ldt_, mode_, roff_, f8_) if (!found) { const int nit_ = ((K_) / 128) * ((N_) / 64); if (r < nit_) { W = (W_); ldw = (ldw_); WT = (bf16*)(WT_); ldt = (ldt_); nnb = (N_) / 64; mode = (mode_); roff = (roff_); f8 = (f8_); found = true; } else r -= nit_; }
#define TR_ENTRY(W_, K_, N_, ldw_, WT_, ldt_, mode_, roff_) TR_ENTRY8(W_, K_, N_, ldw_, WT_, ldt_, mode_, roff_, 0.f)
        if (WHICH == 1) for (int e = 0; e < NE; ++e) {
            TR_ENTRY8(io->in[18] + (size_t)e * D * FFE, D, FFE, FFE, ws + WS_MW13 + (size_t)e * 2 * FFE * D, D, 1, 0, W13_SCALE)
            TR_ENTRY8(io->in[19] + (size_t)e * D * FFE, D, FFE, FFE, ws + WS_MW13 + (size_t)e * 2 * FFE * D, D, 1, 128, W13_SCALE)
            TR_ENTRY8(io->in[20] + (size_t)e * FFE * D, FFE, D, D, ws + WS_MW2 + (size_t)e * D * FFE, FFE, 0, 0, W2_SCALE)
        }
        if (WHICH == 0 || WHICH == 2) { const int l = WHICH == 2 ? 1 : 0;
            TR_ENTRY(w_in + (size_t)l * D * DIN + 512, D, 3072, DIN, (bf16*)(ws + WS_WIN) + (size_t)l * NIN * D, D, 0, 1024)
            TR_ENTRY(io->in[4] + (size_t)l * 512 * D, 512, D, D, (bf16*)(ws + WS_WF) + (size_t)l * D * 512, 512, 0, 0)
            TR_ENTRY(io->in[5] + (size_t)l * 512 * D, 512, D, D, (bf16*)(ws + WS_WG) + (size_t)l * D * 512, 512, 0, 0)
            TR_ENTRY(io->in[6] + (size_t)l * D * D, D, D, D, (bf16*)(ws + WS_WOUT) + (size_t)l * D * D, D, 0, 0)
        }
        if (WHICH == 3) {
        TR_ENTRY(io->in[13], D, FFD, FFD, (bf16*)(ws + WS_DW13), D, 1, 0)
        TR_ENTRY(io->in[14], D, FFD, FFD, (bf16*)(ws + WS_DW13), D, 1, 128)
        TR_ENTRY(io->in[15], FFD, D, D, (bf16*)(ws + WS_DW2), FFD, 0, 0) }
#undef TR_ENTRY
#undef TR_ENTRY8
        const int nb = r % nnb, kb = r / nnb, n0 = nb * 64; const int drow = mode ? 256 * (n0 >> 7) + roff + (n0 & 127) : roff + n0;
        if (f8 != 0.f) tr_item8(W, ldw, (unsigned char*)WT, ldt, kb * 128, n0, drow, f8, scr, lane); else tr_item(W, ldw, WT, ldt, kb * 128, n0, drow, scr, lane);
    }
}
__device__ __forceinline__ void fold_inproj(ArgsP io, LAS unsigned char* lds, int tid, int l, int wg, int nwg) {
    unsigned char* ws = io->ws; const float* w_in = io->in[3];
    LAS float* za = (LAS float*)lds;
    LAS float* tc = (LAS float*)(lds + 16384);
    __syncthreads();
    if (tid < 128) { tc[tid] = cospif((float)tid * (2.0f / 128.0f)); tc[128 + tid] = sinpif((float)tid * (2.0f / 128.0f)); }
    for (int item = wg; item < 128; item += nwg) {
        const int d0 = item * 8;
        __syncthreads();
        for (int i = tid; i < 8 * 128; i += NWAVES * 64) { const int rr = i >> 7, c4 = (i & 127) * 4; *(LAS f32x4*)(za + rr * 512 + c4) = *(const f32x4*)(w_in + ((size_t)l * D + d0 + rr) * DIN + c4); }
        __syncthreads();
#pragma unroll
        for (int h2 = 0; h2 < 2; ++h2) { const int cc = tid + h2 * 512, pq = cc & 1, j = (cc >> 1) & 127, g = cc >> 8;
            float acc[8];
#pragma unroll
            for (int rr = 0; rr < 8; ++rr) acc[rr] = 0.f;
            const LAS float* tb = tc + pq * 128; const LAS float* zg = za + g * 128;
            for (int c = 0; c < 128; c += 4) { const float w0 = tb[(j * c) & 127], w1 = tb[(j * (c + 1)) & 127], w2 = tb[(j * (c + 2)) & 127], w3 = tb[(j * (c + 3)) & 127];
#pragma unroll
                for (int rr = 0; rr < 8; ++rr) { const f32x4 z = *(const LAS f32x4*)(zg + rr * 512 + c); acc[rr] += (z[0] * w0 + z[1] * w1) + (z[2] * w2 + z[3] * w3); } }
            v4u o; o.x = pk2(acc[0], acc[1]); o.y = pk2(acc[2], acc[3]); o.z = pk2(acc[4], acc[5]); o.w = pk2(acc[6], acc[7]);
            *(GAS v4u*)((bf16*)(ws + WS_WIN) + ((size_t)l * NIN + cc) * D + d0) = o; }
    }
    __syncthreads();
}
__device__ __forceinline__ void p0_prologue(ArgsP io, LAS unsigned char* lds, int tid, int lane, int wave, int vcu, int G) {
    unsigned char* ws = io->ws;
    const float* w_in = io->in[3];
    LAS unsigned* scr = (LAS unsigned*)(lds + wave * 16896);
    const int gw = vcu * NWAVES + wave, NGW = G * NWAVES;
    convert_weights<0>(io, lds, lane, wave, gw, NGW);
    __syncthreads();
    fold_inproj(io, lds, tid, 0, blockIdx.x, G);
    {
        LAS float* cosT = (LAS float*)(lds + 32768);
        for (int m = tid; m < 2048; m += NWAVES * 64) cosT[m] = cospif((float)m * (2.0f / 2048.0f)) * (1.0f / 512.0f);
        __syncthreads();
        for (int i = vcu * (NWAVES * 64) + tid; i < 2048 * 512; i += G * NWAVES * 64) { const int k = i >> 9, s0 = (i & 511) * 8; float v[8];
#pragma unroll
            for (int q = 0; q < 8; ++q) { const int sp = s0 + q; v[q] = sp < 2048 ? cosT[(k * sp) & 2047] : -cosT[(k * (sp - 2048) - 512) & 2047]; }
            v4u o; o.x = pk2(v[0], v[1]); o.y = pk2(v[2], v[3]); o.z = pk2(v[4], v[5]); o.w = pk2(v[6], v[7]);
            *(GAS v4u*)((bf16*)(ws + WS_DFT) + (size_t)k * 4096 + s0) = o; }
    }
    for (int i = vcu * (NWAVES * 64) + tid; i < 2 * 4 * 128 * 128 / 8; i += G * NWAVES * 64) { const f32x4 a = *(const f32x4*)(io->in[7] + (size_t)i * 8), b = *(const f32x4*)(io->in[7] + (size_t)i * 8 + 4);
        v4u o; o.x = pk2(a[0], a[1]); o.y = pk2(a[2], a[3]); o.z = pk2(b[0], b[1]); o.w = pk2(b[2], b[3]); *(GAS v4u*)((bf16*)(ws + WS_WSB) + (size_t)i * 8) = o; }
}

__device__ __forceinline__ void load_row4(const float* row, int lane, f32x4 (&v)[4]) {
    const GAS f32x4* p = (const GAS f32x4*)row + lane;
#pragma unroll
    for (int j = 0; j < 4; ++j) v[j] = p[64 * j];
}
__device__ __forceinline__ void load_row4_nt(const float* row, int lane, f32x4 (&v)[4]) {
    const GAS f32x4* p = (const GAS f32x4*)row + lane;
#pragma unroll
    for (int j = 0; j < 4; ++j) v[j] = __builtin_nontemporal_load(p + 64 * j);
}
__device__ __forceinline__ float sumsq4(const f32x4 (&v)[4]) { float s = 0.f;
#pragma unroll
    for (int j = 0; j < 4; ++j) s += (v[j].x * v[j].x + v[j].y * v[j].y) + (v[j].z * v[j].z + v[j].w * v[j].w);
    return s; }
__device__ __forceinline__ void store_row_bf16(bf16* orow, int lane, const f32x4 (&v)[4]) {
    GAS v2u* o8 = (GAS v2u*)orow + lane;
#pragma unroll
    for (int j = 0; j < 4; ++j) { v2u w; w.x = pk2(v[j].x, v[j].y); w.y = pk2(v[j].z, v[j].w); o8[64 * j] = w; }
}
__device__ __forceinline__ void norm_rows(const float* x, const float* g, bf16* XN, int lane, int wave) {
    const int row0 = blockIdx.x * 64 + wave * 8;
    f32x4 gg[4]; load_row4(g, lane, gg);
#pragma unroll
    for (int h = 0; h < 2; ++h) {
        f32x4 v[4][4];
#pragma unroll
        for (int i = 0; i < 4; ++i) load_row4_nt(x + (size_t)(row0 + h * 4 + i) * D, lane, v[i]);
#pragma unroll
        for (int i = 0; i < 4; ++i) { const float r = 1.0f / sqrtf(wave_sum(sumsq4(v[i])) * (1.0f / D) + RMS_EPS);
#pragma unroll
            for (int j = 0; j < 4; ++j) v[i][j] = v[i][j] * r * gg[j];
            store_row_bf16(XN + (size_t)(row0 + h * 4 + i) * D, lane, v[i]); }
    }
}
template <int MODE, bool ROUTE, bool XN8 = false>
__device__ __forceinline__ void post_rows(ArgsP io, LAS unsigned char* lds, const bf16* Y, const float* xi, float* xo, const float* gpost, const float* gnext, int tid, int lane, int wave) {
    unsigned char* ws = io->ws; bf16* XN = (bf16*)(ws + WS_XN);
    const int row0 = blockIdx.x * 64;
    LAS int* cntL = (LAS int*)(lds + 32768);
    if (ROUTE) { if (tid < 8) cntL[tid] = 0; __syncthreads(); }
    f32x4 gp[4]; load_row4(gpost, lane, gp);
    f32x4 rw[ROUTE ? 32 : 1];
    if (ROUTE) {
#pragma unroll
        for (int j = 0; j < 4; ++j)
#pragma unroll
            for (int q = 0; q < 4; ++q) { const float* p = io->in[16] + (size_t)(4 * lane + 256 * j + q) * 8; rw[2 * (4 * j + q)] = *(const f32x4*)p; rw[2 * (4 * j + q) + 1] = *(const f32x4*)(p + 4); }
    }
    for (int i = 0; i < 8; i += 2) {
        f32x4 y[2][4], v[2][4];
#pragma unroll
        for (int u = 0; u < 2; ++u) { const int row = row0 + wave * 8 + i + u;
            if (MODE == 0) { const GAS v2u* a = (const GAS v2u*)(Y + (size_t)row * D) + lane;
#pragma unroll
                for (int j = 0; j < 4; ++j) { const v2u ua = __builtin_nontemporal_load(a + 64 * j); y[u][j] = (f32x4){bflo(ua.x), bfhi(ua.x), bflo(ua.y), bfhi(ua.y)}; } }
            else { const int* pos = (const int*)(ws + WS_POS); const float* w12 = (const float*)(ws + WS_W12); const bf16* YG = (const bf16*)(ws + WS_YG);
                const int pa = pos[row * 2], pb = pos[row * 2 + 1]; const float wa = w12[row * 2], wb = w12[row * 2 + 1];
                const GAS v2u* a = (const GAS v2u*)(YG + (size_t)pa * D) + lane; const GAS v2u* b = (const GAS v2u*)(YG + (size_t)pb * D) + lane;
#pragma unroll
                for (int j = 0; j < 4; ++j) { const v2u ua = __builtin_nontemporal_load(a + 64 * j), ub = __builtin_nontemporal_load(b + 64 * j);
                    y[u][j] = (f32x4){wa * bflo(ua.x) + wb * bflo(ub.x), wa * bfhi(ua.x) + wb * bfhi(ub.x), wa * bflo(ua.y) + wb * bflo(ub.y), wa * bfhi(ua.y) + wb * bfhi(ub.y)}; } }
            load_row4_nt(xi + (size_t)row * D, lane, v[u]); }
#pragma unroll
        for (int u = 0; u < 2; ++u) { const int row = row0 + wave * 8 + i + u;
            const float r = 1.0f / sqrtf(wave_sum(sumsq4(y[u])) * (1.0f / D) + RMS_EPS);
#pragma unroll
            for (int j = 0; j < 4; ++j) v[u][j] += y[u][j] * r * gp[j];
            { GAS f32x4* o = (GAS f32x4*)(xo + (size_t)row * D) + lane;
#pragma unroll
              for (int j = 0; j < 4; ++j) __builtin_nontemporal_store(v[u][j], o + 64 * j); }
            if (gnext) {
                const float r2 = 1.0f / sqrtf(wave_sum(sumsq4(v[u])) * (1.0f / D) + RMS_EPS);
                const GAS f32x4* gn = (const GAS f32x4*)gnext + lane;
#pragma unroll
                for (int j = 0; j < 4; ++j) v[u][j] = v[u][j] * r2 * gn[64 * j];
                if (XN8) { GAS unsigned* o4 = (GAS unsigned*)((unsigned char*)XN + (size_t)row * D) + lane;
#pragma unroll
                    for (int j = 0; j < 4; ++j) o4[64 * j] = pg8::pack4_fp8(v[u][j].x * ACT_SCALE, v[u][j].y * ACT_SCALE, v[u][j].z * ACT_SCALE, v[u][j].w * ACT_SCALE); }
                else store_row_bf16(XN + (size_t)row * D, lane, v[u]);
                if (ROUTE) {
                    float lg[8];
#pragma unroll
                    for (int e = 0; e < 8; ++e) lg[e] = 0.f;
#pragma unroll
                    for (int j = 0; j < 4; ++j)
#pragma unroll
                        for (int q = 0; q < 4; ++q) { const f32x4 r0 = rw[2 * (4 * j + q)], r1 = rw[2 * (4 * j + q) + 1]; const float hv = v[u][j][q];
                            lg[0] += hv * r0.x; lg[1] += hv * r0.y; lg[2] += hv * r0.z; lg[3] += hv * r0.w; lg[4] += hv * r1.x; lg[5] += hv * r1.y; lg[6] += hv * r1.z; lg[7] += hv * r1.w; }
#pragma unroll
                    for (int e = 0; e < 8; ++e) lg[e] = wave_sum(lg[e]) + io->in[17][e];
                    int i1 = 0; float v1 = lg[0];
#pragma unroll
                    for (int e = 1; e < 8; ++e) if (lg[e] > v1) { v1 = lg[e]; i1 = e; }
                    int i2 = -1; float v2 = -INFINITY;
#pragma unroll
                    for (int e = 0; e < 8; ++e) if (e != i1 && lg[e] > v2) { v2 = lg[e]; i2 = e; }
                    if (lane == 0) { const float ex = __expf(v2 - v1), wa = 1.0f / (1.0f + ex); int* e12 = (int*)(ws + WS_E12); float* w12 = (float*)(ws + WS_W12);
                        e12[row * 2] = i1; e12[row * 2 + 1] = i2; w12[row * 2] = wa; w12[row * 2 + 1] = ex * wa;
                        __hip_atomic_fetch_add(cntL + i1, 1, __ATOMIC_RELAXED, __HIP_MEMORY_SCOPE_WORKGROUP); __hip_atomic_fetch_add(cntL + i2, 1, __ATOMIC_RELAXED, __HIP_MEMORY_SCOPE_WORKGROUP); }
                }
            }
        }
    }
    if (ROUTE) { __syncthreads(); if (tid < 8) ((int*)(ws + WS_WGCNT))[blockIdx.x * 8 + tid] = cntL[tid]; }
}
__device__ __forceinline__ void moe_assign(ArgsP io, LAS unsigned char* lds, int tid, int lane, int wave) {
    unsigned char* ws = io->ws; const int G = gridDim.x, me = blockIdx.x;
    LAS int* part = (LAS int*)lds;
    LAS int* offL = part + 64;
    LAS int* baseL = offL + 16;
    LAS int* w0cnt = baseL + 8;
    LAS int* posL = w0cnt + 8;
    const int* wgcnt = (const int*)(ws + WS_WGCNT);
    if (tid < 256) { int c[8];
        if (tid < G) { const int4 a = *(const int4*)(wgcnt + tid * 8), b = *(const int4*)(wgcnt + tid * 8 + 4); c[0] = a.x; c[1] = a.y; c[2] = a.z; c[3] = a.w; c[4] = b.x; c[5] = b.y; c[6] = b.z; c[7] = b.w; }
        else {
#pragma unroll
            for (int e = 0; e < 8; ++e) c[e] = 0; }
#pragma unroll
        for (int e = 0; e < 8; ++e) { int tb = (tid < me) ? c[e] : 0, tt = c[e];
#pragma unroll
            for (int o = 1; o < 64; o <<= 1) { tb += __shfl_xor(tb, o); tt += __shfl_xor(tt, o); }
            if (lane == 0) { part[wave * 16 + e] = tb; part[wave * 16 + 8 + e] = tt; } }
    }
    __syncthreads();
    if (tid == 0) { int off = 0;
        for (int e = 0; e < 8; ++e) { const int tot = part[8 + e] + part[24 + e] + part[40 + e] + part[56 + e]; baseL[e] = part[e] + part[16 + e] + part[32 + e] + part[48 + e]; offL[e] = off; off += (tot + 255) & ~255; }
        offL[8] = off; }
    __syncthreads();
    const int* e12 = (const int*)(ws + WS_E12); int* pos = (int*)(ws + WS_POS);
    if (tid < 128) { const int a = me * 128 + tid; const int e = e12[a]; int rank = 0, cnt_in_w0 = 0;
#pragma unroll
        for (int q = 0; q < 8; ++q) { const unsigned long long m = __ballot(e == q); if (e == q) rank = __popcll(m & ((1ull << lane) - 1ull)); if (wave == 0 && lane == q) cnt_in_w0 = __popcll(m); }
        if (wave == 0 && lane < 8) w0cnt[lane] = cnt_in_w0;
        posL[tid] = rank | (e << 16); }
    __syncthreads();
    if (tid < 128) { const int e = posL[tid] >> 16; const int p = offL[e] + baseL[e] + (posL[tid] & 0xffff) + (tid >= 64 ? w0cnt[e] : 0); pos[me * 128 + tid] = p; posL[tid] = p; }
    __syncthreads();
    const unsigned char* XN = (const unsigned char*)(ws + WS_XN); unsigned char* XG = (unsigned char*)(ws + WS_XG);
    { v4u rowv[16];
#pragma unroll
      for (int q = 0; q < 16; ++q) { const int a = wave + NWAVES * q; const int tok = me * 64 + (a >> 1); rowv[q] = *((const GAS v4u*)(XN + (size_t)tok * D) + lane); }
#pragma unroll
      for (int q = 0; q < 16; ++q) { const int a = wave + NWAVES * q; *((GAS v4u*)(XG + (size_t)posL[a] * D) + lane) = rowv[q]; } }
    if (me == 0) { int* texp = (int*)(ws + WS_TEXP);
        if (tid < NT_MAX) { int te = -1;
#pragma unroll
            for (int e = 0; e < 8; ++e) if (tid * 256 >= offL[e] && tid * 256 < offL[e + 1]) te = e;
            texp[tid] = te; }
        if (tid == 0) ((unsigned*)(ws + WS_CTL))[CW_NTILES] = (unsigned)(offL[8] >> 8); }
}
__device__ __forceinline__ void sgu_phase(ArgsP io, LAS unsigned char* lds, int l, int tid, int lane, int wave, int vcu, int G) {
    unsigned char* ws = io->ws;
    const bf16* GU = (const bf16*)(ws + WS_GU); const bf16* GV = (const bf16*)(ws + WS_GV); bf16* SG = (bf16*)(ws + WS_SG);
    const bf16* Wsb = (const bf16*)(ws + WS_WSB) + (size_t)l * 4 * 128 * 128;
    const float* lg = io->in[9] + l * 512; const float* lb = io->in[10] + l * 512; const float* bs = io->in[8] + l * 512;
    LAS bf16* VNT = (LAS bf16*)lds;
    const int q = tid >> 2, sub = tid & 3, fr = lane & 15, fq = lane >> 4;
    for (int u = vcu; u < 512; u += G) {
        const int c = u >> 2, g = u & 3, base = c * 128;
        const bf16* vrow = GV + (size_t)(base + q) * 512;
        float s = 0.f, ss = 0.f;
#pragma unroll
        for (int i = 0; i < 16; ++i) { const v4u w = *(const GAS v4u*)(vrow + sub * 128 + i * 8);
            const float a0 = bflo(w.x), a1 = bfhi(w.x), a2 = bflo(w.y), a3 = bfhi(w.y), a4 = bflo(w.z), a5 = bfhi(w.z), a6 = bflo(w.w), a7 = bfhi(w.w);
            s += ((a0 + a1) + (a2 + a3)) + ((a4 + a5) + (a6 + a7)); ss += ((a0 * a0 + a1 * a1) + (a2 * a2 + a3 * a3)) + ((a4 * a4 + a5 * a5) + (a6 * a6 + a7 * a7)); }
        s += __shfl_xor(s, 1); s += __shfl_xor(s, 2); ss += __shfl_xor(ss, 1); ss += __shfl_xor(ss, 2);
        const float mu = s * (1.0f / 512.0f); const float var = fmaxf(ss * (1.0f / 512.0f) - mu * mu, 0.f); const float rs = 1.0f / sqrtf(var + LN_EPS);
        __syncthreads();
#pragma unroll
        for (int i = 0; i < 4; ++i) { const int d0 = sub * 32 + i * 8; const v4u w = *(const GAS v4u*)(vrow + g * 128 + d0);
            const f32x4 ga = *(const f32x4*)(lg + g * 128 + d0), gb = *(const f32x4*)(lg + g * 128 + d0 + 4), ba = *(const f32x4*)(lb + g * 128 + d0), bb = *(const f32x4*)(lb + g * 128 + d0 + 4);
            float o[8] = {bflo(w.x), bfhi(w.x), bflo(w.y), bfhi(w.y), bflo(w.z), bfhi(w.z), bflo(w.w), bfhi(w.w)};
            const float gg[8] = {ga[0], ga[1], ga[2], ga[3], gb[0], gb[1], gb[2], gb[3]}; const float bbv[8] = {ba[0], ba[1], ba[2], ba[3], bb[0], bb[1], bb[2], bb[3]};
#pragma unroll
            for (int k = 0; k < 8; k += 2) { const unsigned pw = pk2((o[k] - mu) * rs * gg[k] + bbv[k], (o[k + 1] - mu) * rs * gg[k + 1] + bbv[k + 1]);
                VNT[(d0 + k) * 136 + q] = (bf16)(pw & 0xffffu); VNT[(d0 + k + 1) * 136 + q] = (bf16)(pw >> 16); } }
        __syncthreads();
        f32x4 acc[8];
#pragma unroll
        for (int nt = 0; nt < 8; ++nt) acc[nt] = (f32x4){0.f, 0.f, 0.f, 0.f};
        const bf16* wrow = Wsb + ((size_t)g * 128 + 16 * wave + fr) * 128 + 8 * fq;
#pragma unroll
        for (int ks = 0; ks < 4; ++ks) { const bf16x8 a = *(const GAS bf16x8*)(wrow + 32 * ks);
#pragma unroll
            for (int nt = 0; nt < 8; ++nt) { const bf16x8 b = *(const LAS bf16x8*)(VNT + (16 * nt + fr) * 136 + 32 * ks + 8 * fq); acc[nt] = __builtin_amdgcn_mfma_f32_16x16x32_bf16(b, a, acc[nt], 0, 0, 0); } }
        const int p = 16 * wave + fr; const float bias = bs[g * 128 + p]; const size_t ro = (size_t)(base + p) * 512 + g * 128 + 4 * fq;
#pragma unroll
        for (int nt = 0; nt < 8; ++nt) { const v2u uw = *(const GAS v2u*)(GU + ro + 16 * nt);
            v2u o; o.x = pk2(bflo(uw.x) * (acc[nt][0] + bias), bfhi(uw.x) * (acc[nt][1] + bias)); o.y = pk2(bflo(uw.y) * (acc[nt][2] + bias), bfhi(uw.y) * (acc[nt][3] + bias));
            *(GAS v2u*)(SG + ro + 16 * nt) = o; }
    }
    __syncthreads();
}
#ifndef GP_ALIGN
#define GP_ALIGN true
#endif
#ifndef GP_SP2
#define GP_SP2 true
#endif
constexpr int N_PHASES = 19;
__global__ void __launch_bounds__(NWAVES * 64, 2) mega_fwd(Args args) {
    extern __shared__ __attribute__((aligned(16))) unsigned char lds_raw[];
    LAS unsigned char* lds = (LAS unsigned char*)lds_raw;
    volatile LAS unsigned* MISC = (volatile LAS unsigned*)(lds + LDS_MISC);
#define PH_IDS int tid = threadIdx.x; asm volatile("" : "+v"(tid)); const int lane = tid & 63, wave = __builtin_amdgcn_readfirstlane(tid >> 6); (void)lane; (void)wave;
#define PH_GRID int bx = blockIdx.x, G = gridDim.x; asm volatile("" : "+s"(bx), "+s"(G)); const int vcu = (G % 8 == 0) ? (bx % 8) * (G / 8) + bx / 8 : bx; (void)vcu;
    unsigned char* ws0 = kargs()->ws;
#define XFLAGS (io->flags)
#define PH_WS const ArgsP io = kargs(); unsigned char* ws = io->ws;
    gu32* ctl = (gu32*)(ws0 + WS_CTL);
    for (int u = threadIdx.x; u < (LDS_BYTES - LDS_MISC) / 4; u += NWAVES * 64) ((LAS unsigned*)(lds + LDS_MISC))[u] = 0u;
    __syncthreads();
    XcdBarrier bar = xcd_barrier_post((unsigned*)(ctl + CW_BAR), MISC + 8);
    const int lo = kargs()->ph_lo, hi = kargs()->ph_hi;
#define OPQ(x) ({ int x_ = (x); asm volatile("" : "+s"(x_)); x_; })
#define IN(k) (OPQ(lo) <= (k) && (k) < OPQ(hi))
#define SEAM(k) do { if (IN((k) + 1)) { XcdBarrier b2_ = bar; asm volatile("" : "+s"(b2_.bar)); xcd_barrier(b2_); } } while (0)
#define XN ((bf16*)(ws + WS_XN))
    const size_t T1K = (size_t)256 * 1024 * 2, T512 = (size_t)256 * 512 * 2;

    if (IN(0)) { PH_WS PH_GRID PH_IDS p0_prologue(io, lds, tid, lane, wave, vcu, G); norm_rows(io->in[0], io->in[1], XN, lane, wave); SEAM(0); }

    for (int l = 0; l < 2; ++l) {
        const int pb = 1 + 8 * l;
        if (IN(pb)) { PH_WS PH_GRID
            pg8::SchedInProj Sd{(const char*)XN, (const char*)(ws + WS_WIN) + (size_t)l * NIN * D * 2, T1K, G, bx};
            pg8::EpiInProj E{(bf16*)(ws + WS_PQT), (bf16*)(ws + WS_GU), (bf16*)(ws + WS_GV), (bf16*)(ws + WS_G0), (bf16*)(ws + WS_G1)};
            pg8::gemm_phase<pg8::EpiInProj, pg8::SchedInProj, GP_ALIGN, GP_SP2>(lds, D, Sd, E, XFLAGS);
            SEAM(pb);
        }
        if (IN(pb + 1)) { PH_WS PH_GRID
            if (l == 0) { PH_IDS sgu_phase(io, lds, l, tid, lane, wave, vcu, G); }
            else if (bx >= G / 2) { PH_IDS sgu_phase(io, lds, l, tid, lane, wave, bx - G / 2, G - G / 2); }
            if (l == 0 && bx >= G / 2) { PH_IDS convert_weights<1>(io, lds, lane, wave, (bx - G / 2) * NWAVES + wave, (G - G / 2) * NWAVES); __syncthreads(); }
            pg8::SchedPlain Sd{(const char*)(ws + WS_DFT), (const char*)(ws + WS_PQT), (size_t)256 * 4096 * 2, (size_t)256 * 4096 * 2, 8, 16, G, bx};
            pg8::EpiDft E{(bf16*)(ws + WS_FA)};
            pg8::gemm_phase<pg8::EpiDft, pg8::SchedPlain, GP_ALIGN, GP_SP2>(lds, 4096, Sd, E, XFLAGS);
            if (l == 0 && bx < G / 2) { PH_IDS convert_weights<3>(io, lds, lane, wave, bx * NWAVES + wave, (G / 2) * NWAVES); }
            SEAM(pb + 1);
        }
        if (IN(pb + 2)) { PH_WS PH_GRID
            pg8::SchedMerge Sd{(const char*)(ws + WS_FA), (const char*)(ws + WS_WF) + (size_t)l * D * 512 * 2, (const char*)(ws + WS_SG), (const char*)(ws + WS_WG) + (size_t)l * D * 512 * 2, T512, G, bx};
            pg8::EpiGate2 E{(const bf16*)(ws + WS_G0), (const bf16*)(ws + WS_G1), (bf16*)(ws + WS_MM)};
            pg8::gemm_phase<pg8::EpiGate2, pg8::SchedMerge, GP_ALIGN, GP_SP2>(lds, 512, Sd, E, XFLAGS);
            SEAM(pb + 2);
        }
        if (IN(pb + 3)) { PH_WS PH_GRID
            pg8::SchedPlain Sd{(const char*)(ws + WS_MM), (const char*)(ws + WS_WOUT) + (size_t)l * D * D * 2, T1K, T1K, 64, 4, G, bx};
            pg8::EpiBf16Plain E{(bf16*)(ws + WS_Y), D};
            pg8::gemm_phase<pg8::EpiBf16Plain, pg8::SchedPlain, GP_ALIGN, GP_SP2>(lds, D, Sd, E, XFLAGS);
            SEAM(pb + 3);
        }
        if (IN(pb + 4)) { PH_WS PH_GRID PH_IDS
            const float* xi = (l == 0) ? io->in[0] : (const float*)io->out;
            if (l == 0) post_rows<0, false>(io, lds, (const bf16*)(ws + WS_Y), xi, io->out, io->in[2] + l * D, io->in[11] + l * D, tid, lane, wave);
            else        post_rows<0, true, true>(io, lds, (const bf16*)(ws + WS_Y), xi, io->out, io->in[2] + l * D, io->in[11] + l * D, tid, lane, wave);
            SEAM(pb + 4);
        }
        if (l == 0) {
            if (IN(pb + 5)) { PH_WS PH_GRID
                pg8::SchedPlain Sd{(const char*)XN, (const char*)(ws + WS_DW13), T1K, T1K, 64, 2 * FFD / 256, G, bx};
                pg8::EpiSwiglu E{(bf16*)(ws + WS_HD), FFD};
                pg8::gemm_phase<pg8::EpiSwiglu, pg8::SchedPlain, GP_ALIGN, GP_SP2>(lds, D, Sd, E, XFLAGS);
                if (bx >= G / 2) { PH_IDS convert_weights<2>(io, lds, lane, wave, (bx - G / 2) * NWAVES + wave, (G - G / 2) * NWAVES); fold_inproj(io, lds, tid, 1, bx - G / 2, G - G / 2); }
                SEAM(pb + 5);
            }
            if (IN(pb + 6)) { PH_WS PH_GRID
                pg8::SchedPlain Sd{(const char*)(ws + WS_HD), (const char*)(ws + WS_DW2), (size_t)256 * FFD * 2, (size_t)256 * FFD * 2, 64, 4, G, bx};
                pg8::EpiBf16Plain E{(bf16*)(ws + WS_YD), D};
                pg8::gemm_phase<pg8::EpiBf16Plain, pg8::SchedPlain, GP_ALIGN, GP_SP2>(lds, FFD, Sd, E, XFLAGS);
                SEAM(pb + 6);
            }
            if (IN(pb + 7)) { PH_WS PH_GRID PH_IDS post_rows<0, false>(io, lds, (const bf16*)(ws + WS_YD), (const float*)io->out, io->out, io->in[12], io->in[1] + D, tid, lane, wave); SEAM(pb + 7); }
        } else {
            if (IN(14)) { PH_WS PH_GRID PH_IDS moe_assign(io, lds, tid, lane, wave); SEAM(14); }
            const int ntiles = (int)__builtin_amdgcn_readfirstlane(__hip_atomic_load(ctl + CW_NTILES, RLX_AGENT));
            LAS int* texpL = (LAS int*)(lds + LDS_TEXP);
            if (OPQ(lo) <= 17 && OPQ(hi) > 15) { PH_IDS if (tid < NT_MAX) texpL[tid] = ((const int*)(kargs()->ws + WS_TEXP))[tid]; __syncthreads(); }
            const int nA = ntiles - CHUNK_TILES;
            for (int s = 0; s < 3; ++s) {
                if (IN(15 + s)) { PH_WS PH_GRID
                    if (s >= 1 && !(s == 1 && (XFLAGS & 2))) {
                        const int t0 = (s == 1) ? 0 : nA, nM = (s == 1) ? nA : CHUNK_TILES;
                        pg8::SchedMoe Sd{(const char*)(ws + (s == 1 ? WS_HM : WS_HM2)), (size_t)256 * FFE, (const char*)(ws + WS_MW2), (size_t)D * FFE, (size_t)256 * FFE, texpL, t0, nM, 4, G, bx, 0};
                        pg8::EpiBf16Scaled E{(bf16*)(ws + WS_YG) + (size_t)t0 * 256 * D, D, 1.0f / (ACT_SCALE * W2_SCALE)};
                        pg8::gemm_phase<pg8::EpiBf16Scaled, pg8::SchedMoe, GP_ALIGN, GP_SP2, true>(lds, FFE / 2, Sd, E, XFLAGS);
                    }
                    if (s <= 1 && !(s == 1 && (XFLAGS & 4))) {
                        const int t0 = (s == 0) ? 0 : nA, nM = (s == 0) ? nA : CHUNK_TILES, n2 = (s == 0) ? 0 : 4 * nA - G;
                        pg8::SchedMoe Sd{(const char*)(ws + WS_XG) + (size_t)t0 * T512, T512, (const char*)(ws + WS_MW13), (size_t)2 * FFE * D, T512, texpL, t0, nM, 2 * FFE / 256, G, bx, n2 < 0 ? 0 : n2};
                        pg8::EpiSwiglu8 E{ws + (s == 0 ? WS_HM : WS_HM2), FFE, 1.0f / (ACT_SCALE * W13_SCALE), ACT_SCALE};
                        pg8::gemm_phase<pg8::EpiSwiglu8, pg8::SchedMoe, GP_ALIGN, GP_SP2, true>(lds, D / 2, Sd, E, XFLAGS);
                    }
                    SEAM(15 + s);
                }
            }
            if (IN(18)) { PH_WS PH_GRID PH_IDS post_rows<1, false>(io, lds, nullptr, (const float*)io->out, io->out, io->in[12] + D, nullptr, tid, lane, wave); }
        }
    }
#undef IN
#undef OPQ
#undef SEAM
#undef XN
}

static int g_grid = 0;
static bool mega_setup() {
    if (g_grid != 0) return g_grid > 0;
    int dev = 0, cus = 0, per_cu = 0;
    if (hipGetDevice(&dev) != hipSuccess || hipDeviceGetAttribute(&cus, hipDeviceAttributeMultiprocessorCount, dev) != hipSuccess) { fprintf(stderr, "kernel_launch: device query failed\n"); g_grid = -1; return false; }
    if (hipFuncSetAttribute((const void*)mega_fwd, hipFuncAttributeMaxDynamicSharedMemorySize, LDS_BYTES) != hipSuccess) { fprintf(stderr, "kernel_launch: hipFuncSetAttribute failed\n"); g_grid = -1; return false; }
    if (hipOccupancyMaxActiveBlocksPerMultiprocessor(&per_cu, (const void*)mega_fwd, NWAVES * 64, LDS_BYTES) != hipSuccess || per_cu < 1) fprintf(stderr, "kernel_launch: note: occupancy query reports %d workgroups per CU\n", per_cu);
    (void)hipGetLastError();
    g_grid = cus;
    if (g_grid != 256) fprintf(stderr, "kernel_launch: %d CUs; this kernel's thin phases are dealt for 256 workgroups\n", g_grid);
    return true;
}
static void mega_launch(void* const* d_in, void* d_out, void* d_ws, hipStream_t stream, int lo, int hi, int flags = 0) {
    Args a{};
    for (int i = 0; i < 21; ++i) a.in[i] = (const float*)d_in[i];
    a.out = (float*)d_out; a.ws = (unsigned char*)d_ws; a.ph_lo = lo; a.ph_hi = hi; a.flags = flags; a.pad = 0;
    hipLaunchKernelGGL(mega_fwd, dim3(g_grid), dim3(NWAVES * 64), LDS_BYTES, stream, a);
}
#if MEGA_DEBUG
enum { CM_BF16 = 0, CM_F32 = 1, CM_PQ = 2, CM_GUV = 3, CM_G01 = 4, CM_MOEY = 5, CM_FP8 = 6 };
__device__ __forceinline__ float dbg_e4m3(unsigned char v) { const int s = v >> 7, e = (v >> 3) & 15, m = v & 7; const float mag = e ? ldexpf(1.0f + m * 0.125f, e - 7) : ldexpf(m * 0.125f, -6); return s ? -mag : mag; }
__device__ __forceinline__ float dbg_bf(const unsigned short* p, size_t i) { return __uint_as_float((unsigned)p[i] << 16); }
__global__ __launch_bounds__(256) void cmp_k(int mode, const float* __restrict__ snap, const unsigned char* __restrict__ ws, const float* __restrict__ fbuf, size_t off, int ld, int rows, float* E2) {
    const size_t idx = (size_t)blockIdx.x * 256 + threadIdx.x;
    const size_t total = (size_t)rows * ld;
    float a = 0.f, b = 0.f;
    if (idx < total) {
        const size_t r = idx / ld; const int c = (int)(idx % ld);
        if (mode == CM_BF16) { a = snap[idx]; b = dbg_bf((const unsigned short*)(ws + off), idx); }
        else if (mode == CM_F32) { a = snap[idx]; b = fbuf[idx]; }
        else if (mode == CM_FP8) { a = snap[idx]; b = dbg_e4m3((ws + off)[idx]) * (1.0f / ACT_SCALE); }
        else if (mode == CM_PQ) {
            const int pq = c >> 9, ch = c & 511, g = ch >> 7, j = ch & 127; a = snap[(size_t)pq * rows * 512 + r * 512 + ch];
            const int bb = (int)(r >> 11), s = (int)(r & 2047); b = dbg_bf((const unsigned short*)(ws + WS_PQT), ((size_t)bb * 1024 + (g * 128 + j) * 2 + pq) * 2048 + s); }
        else if (mode == CM_GUV) { const float z = snap[idx]; a = 0.5f * z * (1.0f + erff(z * 0.70710678f));
            b = c < 512 ? dbg_bf((const unsigned short*)(ws + WS_GU), r * 512 + c) : dbg_bf((const unsigned short*)(ws + WS_GV), r * 512 + c - 512); }
        else if (mode == CM_G01) { const float z = snap[idx]; a = 1.0f / (1.0f + expf(-z));
#ifdef DBG_RAWGATE
            a = z;
#endif
#ifdef DBG_G0ONLY
            if (c >= 1024) { a = 0.f; }
#endif

            b = c < 1024 ? dbg_bf((const unsigned short*)(ws + WS_G0), r * 1024 + c) : dbg_bf((const unsigned short*)(ws + WS_G1), r * 1024 + c - 1024);
#ifdef DBG_G0ONLY
            if (c >= 1024) b = 0.f;
#endif
            }
        else { a = snap[idx]; const int* pos = (const int*)(ws + WS_POS); const float* w12 = (const float*)(ws + WS_W12); const unsigned short* YG = (const unsigned short*)(ws + WS_YG);
            b = w12[r * 2] * dbg_bf(YG, (size_t)pos[r * 2] * 1024 + c) + w12[r * 2 + 1] * dbg_bf(YG, (size_t)pos[r * 2 + 1] * 1024 + c); }
    }
    float num = (a - b) * (a - b), den = a * a;
#pragma unroll
    for (int o = 1; o < 64; o <<= 1) { num += __shfl_xor(num, o); den += __shfl_xor(den, o); }
    if ((threadIdx.x & 63) == 0) { atomicAdd(E2, num); atomicAdd(E2 + 1, den); }
}
struct Chk { int stage, hi, mode; size_t off; int ld; float thr; };
#ifndef DBG_FIRST
#define DBG_FIRST 0
#endif
#ifndef DBG_LAST
#define DBG_LAST 24
#endif
#ifndef DBG_VALUE_OF
#define DBG_VALUE_OF (-1)
#endif
constexpr int N_CHK = 25;
__global__ __launch_bounds__(256) void dbg_scale_k(float* x, size_t n, const float* E2, int first, int last, int value_of, float thr0, float thr1) {
    float sc = 1.0f;
    if (value_of >= 0) { const float e = sqrtf(E2[2 * value_of] / fmaxf(E2[2 * value_of + 1], 1e-30f)); sc = 1.0f + (e == e ? fminf(e, 2.0f) : 3.0f); }
    else { for (int k = first; k <= last; ++k) { const float thr = (k >= 23) ? thr1 : thr0; const float num = E2[2 * k], den = E2[2 * k + 1]; if (!(num <= thr * thr * den) || !(den > 0.f)) { sc = 1.0f + 0.04f * (float)(k + 1); break; } } }
    const size_t i = (size_t)blockIdx.x * 256 + threadIdx.x; if (i < n) x[i] *= sc;
}
#endif

extern "C" void kernel_launch(void* const* d_in, const int* in_sizes, int n_in, void* d_out, int out_size, void* d_ws, size_t ws_size, hipStream_t stream) {
    if (!mega_setup()) return;
#if !MEGA_DEBUG
    if (hipMemsetAsync((char*)d_ws + WS_CTL, 0, CTL_ZERO_BYTES, stream) != hipSuccess) return;
#ifdef MEGA_PARTIAL_HI
#ifndef MEGA_PARTIAL_FLAGS
#define MEGA_PARTIAL_FLAGS 0
#endif
    mega_launch(d_in, d_out, d_ws, stream, 0, MEGA_PARTIAL_HI, MEGA_PARTIAL_FLAGS);
    if (hipMemsetAsync((char*)d_ws + WS_CTL, 0, CTL_ZERO_BYTES, stream) != hipSuccess) return;
#endif
    mega_launch(d_in, d_out, d_ws, stream, 0, N_PHASES);
#else
    const Chk chk[N_CHK] = {
        {1, 1, CM_BF16, WS_XN, 1024, 0}, {2, 2, CM_PQ, 0, 1024, 0}, {3, 2, CM_GUV, 0, 1024, 0}, {4, 2, CM_G01, 0, 2048, 0}, {5, 3, CM_BF16, WS_FA, 512, 0}, {6, 3, CM_BF16, WS_SG, 512, 0},
        {7, 4, CM_BF16, WS_MM, 1024, 0}, {8, 5, CM_BF16, WS_Y, 1024, 0}, {9, 6, CM_F32, (size_t)-1, 1024, 0}, {10, 6, CM_BF16, WS_XN, 1024, 0}, {11, 7, CM_BF16, WS_HD, 2816, 0}, {12, 8, CM_BF16, WS_YD, 1024, 0},
        {13, 9, CM_F32, (size_t)-1, 1024, 0},
        {21, 9, CM_BF16, WS_XN, 1024, 0}, {22, 10, CM_PQ, 0, 1024, 0}, {23, 10, CM_GUV, 0, 1024, 0}, {24, 10, CM_G01, 0, 2048, 0}, {25, 11, CM_BF16, WS_FA, 512, 0}, {26, 11, CM_BF16, WS_SG, 512, 0},
        {27, 12, CM_BF16, WS_MM, 1024, 0}, {28, 13, CM_BF16, WS_Y, 1024, 0}, {29, 14, CM_F32, (size_t)-1, 1024, 0}, {30, 14, CM_FP8, WS_XN, 1024, 0}, {32, 18, CM_MOEY, 0, 1024, 0}, {33, 19, CM_F32, (size_t)-1, 1024, 0} };
    const int R = 2048;
    float* SAFE = (float*)((char*)d_ws + 445 * MiB); float* E2 = (float*)((char*)d_ws + 476 * MiB);
    hipMemsetAsync(E2, 0, 4096, stream);
    for (int k = DBG_FIRST; k <= DBG_LAST; ++k) {
        nv::naive_run(d_in, (float*)d_out, d_ws, stream, R, chk[k].stage, SAFE);
        hipMemsetAsync((char*)d_ws + WS_CTL, 0, CTL_ZERO_BYTES, stream);
        mega_launch(d_in, d_out, d_ws, stream, 0, chk[k].hi);
        const float* fb = chk[k].off == (size_t)-1 ? (const float*)d_out : (const float*)((char*)d_ws + chk[k].off);
        const size_t total = (size_t)R * chk[k].ld;
        hipLaunchKernelGGL(cmp_k, dim3((unsigned)((total + 255) / 256)), dim3(256), 0, stream, chk[k].mode, (const float*)SAFE, (const unsigned char*)d_ws, fb, chk[k].off, chk[k].ld, R, E2 + 2 * k);
    }
    nv::naive_run(d_in, (float*)d_out, d_ws, stream, T, -1, nullptr);
    hipLaunchKernelGGL(dbg_scale_k, dim3((unsigned)(((size_t)T * D + 255) / 256)), dim3(256), 0, stream, (float*)d_out, (size_t)T * D, (const float*)E2, DBG_FIRST, DBG_LAST, DBG_VALUE_OF, 0.05f, 0.3f);
#endif
}
```

```cpp
#include <hip/hip_runtime.h>
#include <cstdio>
#include <cstdint>
#include <math.h>
#define MEGA_DEBUG 0

namespace pg8 {
#define PG8_LAS __attribute__((address_space(3)))
typedef unsigned short bf16_t;
typedef short bf16x8 __attribute__((ext_vector_type(8)));
typedef float f32x4 __attribute__((ext_vector_type(4)));
typedef unsigned u32x4 __attribute__((ext_vector_type(4)));
constexpr int BM = 256, BK = 64, HALF = 128, HTB = HALF * BK * 2  , STAGE_BYTES = 8 * HTB, NXCD = 8, WGM = 8;

__host__ __device__ __forceinline__ int lds_byte(int r, int c) { const int st = (r >> 4) * 2 + (c >> 5), rr = r & 15, cc = c & 31, ob = rr * 64 + cc * 2; return st * 1024 + (ob ^ (((ob >> 9) & 1) << 5)); }
__host__ __device__ __forceinline__ void stage_rc(int b, int& R, int& C) { const int st = b / 1024, sb = b % 1024, swz = sb ^ (((sb >> 9) & 1) << 5); R = (st >> 1) * 16 + swz / 64; C = (st & 1) * 32 + (swz % 64) / 2; }
__host__ __device__ __forceinline__ int perm32(int rho) { const int n = rho >> 4, i = rho & 15; return 8 * (i >> 2) + 4 * n + (i & 3); }

struct Unit { const char* a; const char* b; int r0, c0, tag; };

__device__ __forceinline__ bool order_xy(long L, int nM, int nN, int& pm, int& pn) {
    const int nwg = nM * nN; if (L >= nwg) return false;
    int wgid = (int)L; { const int q = nwg / NXCD, r = nwg % NXCD, xcd = wgid % NXCD, off = wgid / NXCD; wgid = (xcd < r ? xcd * (q + 1) : r * (q + 1) + (xcd - r) * q) + off; }
    const int nig = WGM * nN, gid = wgid / nig, fm = gid * WGM, gsz = (nM - fm) < WGM ? (nM - fm) : WGM;
    pm = fm + ((wgid % nig) % gsz); pn = (wgid % nig) / gsz; return true;
}
struct SchedPlain {
    const char* A; const char* B; size_t ta, tb; int nM, nN, G, c;
    __device__ __forceinline__ bool next(int i, Unit& u) const { int pm, pn; if (!order_xy((long)i * G + c, nM, nN, pm, pn)) return false;
        u.a = A + (size_t)pm * ta; u.b = B + (size_t)pn * tb; u.r0 = pm; u.c0 = pn; u.tag = 0; return true; }
    __device__ __forceinline__ void a_ready(const Unit&) const {}
    __device__ __forceinline__ void done(const Unit&) const {}
};
struct SchedInProj {
    const char* XN; const char* W; size_t t; int G, c;
    __device__ __forceinline__ bool next(int i, Unit& u) const { int pm, pn; if (!order_xy((long)i * G + c, 64, 16, pm, pn)) return false;
        if (pn < 4) { u.a = W + (size_t)pn * t; u.b = XN + (size_t)pm * t; u.r0 = pn; u.c0 = pm; u.tag = 1; }
        else        { u.a = XN + (size_t)pm * t; u.b = W + (size_t)pn * t; u.r0 = pm; u.c0 = pn; u.tag = 0; }
        return true; }
    __device__ __forceinline__ void a_ready(const Unit&) const {}
    __device__ __forceinline__ void done(const Unit&) const {}
};
struct SchedMoe {
    const char* A; size_t ta; const char* W; size_t we, tb; const PG8_LAS int* texp; int t0, nM, nN, G, c, n2;
    __device__ __forceinline__ bool next(int i, Unit& u) const { int pm, pn; const int n1 = G - n2;
        constexpr int SKIP = 4;
        const long L = (c >= n2) ? ((i < SKIP) ? (long)i * n1 + (c - n2) : (long)SKIP * n1 + (long)(i - SKIP) * G + c) : (long)SKIP * n1 + (long)i * G + c;
        if (!order_xy(L, nM, nN, pm, pn)) return false;
        const int e = __builtin_amdgcn_readfirstlane(texp[t0 + pm]);
        u.a = A + (size_t)pm * ta; u.b = W + (size_t)e * we + (size_t)pn * tb; u.r0 = pm; u.c0 = pn; u.tag = 0; return true; }
    __device__ __forceinline__ void a_ready(const Unit&) const {}
    __device__ __forceinline__ void done(const Unit&) const {}
};
struct SchedMerge {
    const char* A0; const char* B0; const char* A1; const char* B1; size_t t; int G, c;
    __device__ __forceinline__ bool next(int i, Unit& u) const { int pm, pn; if (i >= 2 || !order_xy((long)c, 64, 4, pm, pn)) return false;
        u.a = (i ? A1 : A0) + (size_t)pm * t; u.b = (i ? B1 : B0) + (size_t)pn * t; u.r0 = pm; u.c0 = pn; u.tag = i; return true; }
    __device__ __forceinline__ void a_ready(const Unit&) const {}
    __device__ __forceinline__ void done(const Unit&) const {}
};
typedef float f32x2_t __attribute__((ext_vector_type(2)));
typedef __bf16 bf16x2_t __attribute__((ext_vector_type(2)));
__device__ __forceinline__ unsigned cvt_pk_bf16(float lo, float hi) { const f32x2_t v = {lo, hi}; const bf16x2_t b = __builtin_convertvector(v, bf16x2_t); return __builtin_bit_cast(unsigned, b); }
typedef float f32x2 __attribute__((ext_vector_type(2)));
__device__ __forceinline__ f32x2 gelu_pk(f32x2 v) {
    const f32x2 av = __builtin_elementwise_abs(v), d = av * 0.2316418882f + 1.0f;
    f32x2 t; t.x = __builtin_amdgcn_rcpf(d.x); t.y = __builtin_amdgcn_rcpf(d.y);
    f32x2 q = t * 0.5307027145f + (-0.7265760135f); q = q * t + 0.7107068705f; q = q * t + (-0.142248368f); q = q * t + 0.127414796f; q = q * t;
    const f32x2 s = (v * v) * (-0.72134752044f);
    f32x2 e; e.x = __builtin_amdgcn_exp2f(s.x); e.y = __builtin_amdgcn_exp2f(s.y);
    const f32x2 m = v * (q * e), r = v - m;
    f32x2 o; o.x = v.x < 0.f ? m.x : r.x; o.y = v.y < 0.f ? m.y : r.y; return o;
}

typedef int i32x8 __attribute__((ext_vector_type(8)));
typedef int i32x4v __attribute__((ext_vector_type(4)));
__device__ __forceinline__ i32x8 cat8(bf16x8 lo, bf16x8 hi) { return __builtin_shufflevector(__builtin_bit_cast(i32x4v, lo), __builtin_bit_cast(i32x4v, hi), 0, 1, 2, 3, 4, 5, 6, 7); }
__device__ __forceinline__ unsigned pack4_fp8(float a, float b, float c, float d) {
    a = __builtin_amdgcn_fmed3f(a, -448.f, 448.f); b = __builtin_amdgcn_fmed3f(b, -448.f, 448.f); c = __builtin_amdgcn_fmed3f(c, -448.f, 448.f); d = __builtin_amdgcn_fmed3f(d, -448.f, 448.f);
    int w = 0; w = __builtin_amdgcn_cvt_pk_fp8_f32(a, b, w, false); w = __builtin_amdgcn_cvt_pk_fp8_f32(c, d, w, true); return (unsigned)w; }
#ifndef EPI_WT
#define EPI_WT 0
#endif
typedef unsigned u32x2s __attribute__((ext_vector_type(2)));
struct WtBase { __amdgpu_buffer_rsrc_t r; const char* base; };
__device__ __forceinline__ WtBase wt_base() {
    typedef const __attribute__((address_space(4))) unsigned long long* KP;
    KP kp = (KP)__builtin_amdgcn_kernarg_segment_ptr(); asm volatile("" : "+s"(kp));
    char* ws = (char*)kp[22];
    WtBase b; b.r = __builtin_amdgcn_make_buffer_rsrc(ws, 0, 0x7fffffff, 0x00020000); b.base = ws; return b; }
__device__ __forceinline__ void st16(const WtBase& b, void* p, u32x4 w) {
#if EPI_WT
    __builtin_amdgcn_raw_buffer_store_b128(w, b.r, (int)((const char*)p - b.base), 0, 16);
#else
    *(u32x4*)p = w;
#endif
}
__device__ __forceinline__ void st8(const WtBase& b, void* p, u32x2s w) {
#if EPI_WT
    __builtin_amdgcn_raw_buffer_store_b64(w, b.r, (int)((const char*)p - b.base), 0, 16);
#else
    *(u32x2s*)p = w;
#endif
}
__device__ __forceinline__ float sigm_fast(float x) { return __builtin_amdgcn_rcpf(1.0f + __builtin_amdgcn_exp2f(-1.44269504f * x)); }
__device__ __forceinline__ f32x4 act4(f32x4 v, int act) {
    if (act == 1) { const f32x2 a = gelu_pk((f32x2){v[0], v[1]}), b = gelu_pk((f32x2){v[2], v[3]}); return (f32x4){a.x, a.y, b.x, b.y}; }
    if (act == 2) return (f32x4){sigm_fast(v[0]), sigm_fast(v[1]), sigm_fast(v[2]), sigm_fast(v[3])};
    return v;
}
__device__ __forceinline__ u32x4 pack8(f32x4 v0, f32x4 v1) { u32x4 w; w.x = cvt_pk_bf16(v0[0], v0[1]); w.y = cvt_pk_bf16(v0[2], v0[3]); w.z = cvt_pk_bf16(v1[0], v1[1]); w.w = cvt_pk_bf16(v1[2], v1[3]); return w; }
__device__ __forceinline__ void unpack8(u32x4 w, f32x4& v0, f32x4& v1) {
    v0 = (f32x4){__uint_as_float(w.x << 16), __uint_as_float(w.x & 0xffff0000u), __uint_as_float(w.y << 16), __uint_as_float(w.y & 0xffff0000u)};
    v1 = (f32x4){__uint_as_float(w.z << 16), __uint_as_float(w.z & 0xffff0000u), __uint_as_float(w.w << 16), __uint_as_float(w.w & 0xffff0000u)}; }
template <int ACT> __device__ __forceinline__ void store_tile_bf16(const f32x4 (&acc)[2][2][4][2], bf16_t* base, size_t ldc, float sc = 1.0f) {
    const WtBase wb = wt_base();
#pragma unroll
    for (int ai = 0; ai < 2; ++ai)
#pragma unroll
        for (int m = 0; m < 4; ++m) { bf16_t* rowp = base + (size_t)(ai * HALF + m * 16) * ldc;
#pragma unroll
            for (int bj = 0; bj < 2; ++bj) st16(wb, rowp + bj * HALF, pack8(act4(acc[ai][bj][m][0] * sc, ACT), act4(acc[ai][bj][m][1] * sc, ACT))); }
}
__device__ __forceinline__ void store_tile_fp8(const f32x4 (&acc)[2][2][4][2], unsigned char* base, size_t ldc, float s) {
#pragma unroll
    for (int ai = 0; ai < 2; ++ai)
#pragma unroll
        for (int m = 0; m < 4; ++m) { unsigned char* rowp = base + (size_t)(ai * HALF + m * 16) * ldc;
#pragma unroll
            for (int bj = 0; bj < 2; ++bj) { const f32x4 a = acc[ai][bj][m][0] * s, b = acc[ai][bj][m][1] * s; u32x2s w; w.x = pack4_fp8(a[0], a[1], a[2], a[3]); w.y = pack4_fp8(b[0], b[1], b[2], b[3]);
                *(u32x2s*)(rowp + bj * HALF) = w; } }
}
struct EpiInProj {
    static constexpr bool PERM = true, AFTER_DRAIN = false, KEEPS = false;
    bf16_t *PQT, *GU, *GV, *G0, *G1; float sc; float pq8;
    __device__ __forceinline__ void operator()(const f32x4 (&acc)[2][2][4][2], const Unit& u, int wr, int wc, int fr, int fq) const {
        if (u.tag) { const int tok0 = u.c0 * BM, b = tok0 >> 11, s0 = tok0 & 2047;
            if (pq8 != 0.f) store_tile_fp8(acc, (unsigned char*)PQT + ((size_t)b * 1024 + u.r0 * BM + wr * 64 + fr) * 2048 + s0 + wc * 32 + 8 * fq, 2048, sc * pq8);
            else store_tile_bf16<0>(acc, PQT + ((size_t)b * 1024 + u.r0 * BM + wr * 64 + fr) * 2048 + s0 + wc * 32 + 8 * fq, 2048, sc); }
        else { const int wt = u.c0; const size_t row = (size_t)u.r0 * BM + wr * 64 + fr; const int col = wc * 32 + 8 * fq;
            if (wt < 8) { bf16_t* dst = (wt < 6 ? GU : GV) + row * 512 + (wt & 1) * BM + col; store_tile_bf16<1>(acc, dst, 512, sc); }
            else {
                const size_t o0 = row * 1024 + (wt - 8) * HALF + col; const float nl2 = -1.44269504f * sc;
#pragma unroll
                for (int ai = 0; ai < 2; ++ai)
#pragma unroll
                    for (int m = 0; m < 4; ++m) { f32x4 rho[2], g1v[2];
#pragma unroll
                        for (int n = 0; n < 2; ++n)
#pragma unroll
                            for (int i = 0; i < 4; ++i) { const float e0 = fminf(__builtin_amdgcn_exp2f(nl2 * acc[ai][0][m][n][i]), 1e18f), e1 = fminf(__builtin_amdgcn_exp2f(nl2 * acc[ai][1][m][n][i]), 1e18f);
                                const float d1 = 1.0f + e1; g1v[n][i] = __builtin_amdgcn_rcpf(d1); rho[n][i] = d1 * __builtin_amdgcn_rcpf(1.0f + e0); }
                        const size_t o = o0 + (size_t)(ai * HALF + m * 16) * 1024;
                        *(u32x4*)(G0 + o) = pack8(rho[0], rho[1]); *(u32x4*)(G1 + o) = pack8(g1v[0], g1v[1]); }
            } }
    }
};
struct EpiDft {
    static constexpr bool PERM = true, AFTER_DRAIN = false, KEEPS = false;
    bf16_t* FA; float sc;
    __device__ __forceinline__ void operator()(const f32x4 (&acc)[2][2][4][2], const Unit& u, int wr, int wc, int fr, int fq) const {
        const WtBase wb = wt_base();
        const int k0 = u.r0 * BM + wr * 64 + fr;
#pragma unroll
        for (int bj = 0; bj < 2; ++bj) { const int n0 = u.c0 * BM + bj * HALF, b = n0 >> 9, ch = (n0 & 511) + wc * 32 + 8 * fq;
#pragma unroll
            for (int ai = 0; ai < 2; ++ai)
#pragma unroll
                for (int m = 0; m < 4; ++m) st16(wb, FA + ((size_t)b * 2048 + k0 + ai * HALF + m * 16) * 512 + ch, pack8(acc[ai][bj][m][0] * sc, acc[ai][bj][m][1] * sc)); }
    }
};
struct EpiGate2 {
    static constexpr bool PERM = true, AFTER_DRAIN = false, KEEPS = true;
    const bf16_t* RHO; const bf16_t* G1; bf16_t* Mm;
    __device__ __forceinline__ bool keep(const Unit& u) const { return u.tag == 0; }
    __device__ __forceinline__ void operator()(f32x4 (&acc)[2][2][4][2], const Unit& u, int wr, int wc, int fr, int fq) const {
        const size_t off0 = ((size_t)u.r0 * BM + wr * 64 + fr) * 1024 + u.c0 * BM + wc * 32 + 8 * fq;
        const bf16_t* Gt = u.tag ? G1 : RHO;
        u32x4 t[2][4][2];
#pragma unroll
        for (int ai = 0; ai < 2; ++ai)
#pragma unroll
            for (int m = 0; m < 4; ++m)
#pragma unroll
                for (int bj = 0; bj < 2; ++bj) t[ai][m][bj] = *(const u32x4*)(Gt + off0 + (size_t)(ai * HALF + m * 16) * 1024 + bj * HALF);
#pragma unroll
        for (int ai = 0; ai < 2; ++ai)
#pragma unroll
            for (int m = 0; m < 4; ++m)
#pragma unroll
                for (int bj = 0; bj < 2; ++bj) { f32x4 g0, g1; unpack8(t[ai][m][bj], g0, g1); acc[ai][bj][m][0] *= g0; acc[ai][bj][m][1] *= g1; }
        if (u.tag) {
#pragma unroll
            for (int ai = 0; ai < 2; ++ai)
#pragma unroll
                for (int m = 0; m < 4; ++m)
#pragma unroll
                    for (int bj = 0; bj < 2; ++bj) *(u32x4*)(Mm + off0 + (size_t)(ai * HALF + m * 16) * 1024 + bj * HALF) = pack8(acc[ai][bj][m][0], acc[ai][bj][m][1]);
        }
    }
};
struct EpiF32 {
    static constexpr bool PERM = false, AFTER_DRAIN = false, KEEPS = false;
    float* C; int ldc;
    __device__ __forceinline__ void operator()(const f32x4 (&acc)[2][2][4][2], const Unit& u, int wr, int wc, int fr, int fq) const {
        const int row0 = u.r0 * BM + wr * 64 + fr, col0 = u.c0 * BM + wc * 32 + 4 * fq;
#pragma unroll
        for (int ai = 0; ai < 2; ++ai)
#pragma unroll
            for (int m = 0; m < 4; ++m) { float* rowp = C + (size_t)(row0 + ai * HALF + m * 16) * ldc + col0;
#pragma unroll
                for (int bj = 0; bj < 2; ++bj)
#pragma unroll
                    for (int n = 0; n < 2; ++n) *(f32x4*)(rowp + bj * HALF + n * 16) = acc[ai][bj][m][n]; }
    }
};
struct EpiBf16Plain {
    static constexpr bool PERM = true, AFTER_DRAIN = false, KEEPS = false;
    bf16_t* O; int ldc;
    __device__ __forceinline__ void operator()(const f32x4 (&acc)[2][2][4][2], const Unit& u, int wr, int wc, int fr, int fq) const {
        store_tile_bf16<0>(acc, O + ((size_t)u.r0 * BM + wr * 64 + fr) * ldc + u.c0 * BM + wc * 32 + 8 * fq, ldc); }
};
struct EpiSwiglu {
    static constexpr bool PERM = true, AFTER_DRAIN = false, KEEPS = false;
    bf16_t* H; int ldc;
    __device__ __forceinline__ void operator()(const f32x4 (&acc)[2][2][4][2], const Unit& u, int wr, int wc, int fr, int fq) const {
        const WtBase wb = wt_base();
        bf16_t* base = H + ((size_t)u.r0 * BM + wr * 64 + fr) * ldc + u.c0 * HALF + wc * 32 + 8 * fq;
#pragma unroll
        for (int ai = 0; ai < 2; ++ai)
#pragma unroll
            for (int m = 0; m < 4; ++m) { f32x4 v[2];
#pragma unroll
                for (int n = 0; n < 2; ++n) { const f32x4 a = acc[ai][0][m][n], b = acc[ai][1][m][n];
                    v[n] = (f32x4){a[0] * sigm_fast(a[0]) * b[0], a[1] * sigm_fast(a[1]) * b[1], a[2] * sigm_fast(a[2]) * b[2], a[3] * sigm_fast(a[3]) * b[3]}; }
                st16(wb, base + (size_t)(ai * HALF + m * 16) * ldc, pack8(v[0], v[1])); }
    }
};

typedef unsigned u32x2 __attribute__((ext_vector_type(2)));
struct EpiSwiglu8 {
    static constexpr bool PERM = true, AFTER_DRAIN = false, KEEPS = false;
    unsigned char* H; int ldc; float sin, sout;
    __device__ __forceinline__ void operator()(const f32x4 (&acc)[2][2][4][2], const Unit& u, int wr, int wc, int fr, int fq) const {
        const WtBase wb = wt_base();
        unsigned char* base = H + ((size_t)u.r0 * BM + wr * 64 + fr) * ldc + u.c0 * HALF + wc * 32 + 8 * fq;
        const float c1 = -1.44269504f * sin, is2 = 1.0f / (sin * sin * sout);
#pragma unroll
        for (int ai = 0; ai < 2; ++ai)
#pragma unroll
            for (int m = 0; m < 4; ++m) { u32x2 w;
#pragma unroll
                for (int n = 0; n < 2; ++n) { const f32x4 a = acc[ai][0][m][n], b = acc[ai][1][m][n]; float v[4];
#pragma unroll
                    for (int i = 0; i < 4; ++i) v[i] = (a[i] * b[i]) * __builtin_amdgcn_rcpf(__builtin_fmaf(__builtin_amdgcn_exp2f(a[i] * c1), is2, is2));
                    const unsigned pw = pack4_fp8(v[0], v[1], v[2], v[3]); if (n == 0) w.x = pw; else w.y = pw; }
                { u32x2s w2; w2.x = w.x; w2.y = w.y; st8(wb, base + (size_t)(ai * HALF + m * 16) * ldc, w2); } }
    }
};
struct EpiBf16Scaled {
    static constexpr bool PERM = true, AFTER_DRAIN = false, KEEPS = false;
    bf16_t* O; int ldc; float s;
    __device__ __forceinline__ void operator()(const f32x4 (&acc)[2][2][4][2], const Unit& u, int wr, int wc, int fr, int fq) const {
        const WtBase wb = wt_base();
        bf16_t* base = O + ((size_t)u.r0 * BM + wr * 64 + fr) * ldc + u.c0 * BM + wc * 32 + 8 * fq;
#pragma unroll
        for (int ai = 0; ai < 2; ++ai)
#pragma unroll
            for (int m = 0; m < 4; ++m) { bf16_t* rowp = base + (size_t)(ai * HALF + m * 16) * ldc;
#pragma unroll
                for (int bj = 0; bj < 2; ++bj) *(u32x4*)(rowp + bj * HALF) = pack8(acc[ai][bj][m][0] * s, acc[ai][bj][m][1] * s); }
    }
};
template <class Epi, class Sched, bool ALIGN_EPI = false, bool SP2 = false, bool FP8 = false>
__device__ __forceinline__ void gemm_phase(PG8_LAS unsigned char* lds, const int K, const Sched& S, const Epi& E, const int xflags = 0) {
    int tid_ = threadIdx.x; asm volatile("" : "+v"(tid_));
    const int tid = tid_, wid = __builtin_amdgcn_readfirstlane(tid >> 6), lane = tid & 63, wr = wid >> 2, wc = wid & 3, fr = lane & 15, fq = lane >> 4;
    int nt_ = K / BK; asm volatile("" : "+s"(nt_)); const int nt = nt_;
    unsigned voffA[2], voffB[2];
#pragma unroll
    for (int i = 0; i < 2; ++i) { int R, C; stage_rc(tid * 16 + i * 8192, R, C); const int Rb = Epi::PERM ? ((R & ~31) + perm32(R & 31)) : R;
        voffA[i] = (unsigned)(R * K + C) * 2u; voffB[i] = (unsigned)(Rb * K + C) * 2u; }
    const size_t kstep = (size_t)(BK * 2);
    const size_t hstep = (size_t)HALF * K * 2;
    const unsigned ldsw = (unsigned)wid * 1024u;
    const int aoff = lds_byte(wr * 64 + fr, fq * 8), boff = lds_byte(wc * 32 + fr, fq * 8);
#define PG8_SA(b, h) (((b) * 2 + (h)) * HTB)
#define PG8_SB(b, h) ((4 + (b) * 2 + (h)) * HTB)
#define PG8_STAGE(bufoff, gbase, voff) do { _Pragma("unroll") for (int _i = 0; _i < 2; ++_i) \
        __builtin_amdgcn_global_load_lds((const unsigned*)((const char*)(gbase) + (voff)[_i]), (PG8_LAS unsigned*)(lds + (bufoff) + ldsw + _i * 8192), 16, 0, 0); } while (0)
#define PG8_LDA(dst, b, h) do { if constexpr (FP8) { _Pragma("unroll") for (int m = 0; m < 4; ++m) dst##8[m] = cat8(*(const PG8_LAS bf16x8*)(lds + PG8_SA(b, h) + aoff + m * 2048), *(const PG8_LAS bf16x8*)(lds + PG8_SA(b, h) + aoff + m * 2048 + 1024)); } \
    else { _Pragma("unroll") for (int m = 0; m < 4; ++m) _Pragma("unroll") for (int k = 0; k < 2; ++k) dst[m][k] = *(const PG8_LAS bf16x8*)(lds + PG8_SA(b, h) + aoff + m * 2048 + k * 1024); } } while (0)
#define PG8_LDB(dst, b, h) do { if constexpr (FP8) { _Pragma("unroll") for (int n = 0; n < 2; ++n) dst##8[n] = cat8(*(const PG8_LAS bf16x8*)(lds + PG8_SB(b, h) + boff + n * 2048), *(const PG8_LAS bf16x8*)(lds + PG8_SB(b, h) + boff + n * 2048 + 1024)); } \
    else { _Pragma("unroll") for (int n = 0; n < 2; ++n) _Pragma("unroll") for (int k = 0; k < 2; ++k) dst[n][k] = *(const PG8_LAS bf16x8*)(lds + PG8_SB(b, h) + boff + n * 2048 + k * 1024); } } while (0)
#define PG8_MMA(ai, bj, At, Bt) do { if constexpr (FP8) __builtin_amdgcn_sched_barrier(0); __builtin_amdgcn_s_setprio(1); _Pragma("unroll") for (int m = 0; m < 4; ++m) _Pragma("unroll") for (int n = 0; n < 2; ++n) { \
        if constexpr (FP8) asm volatile("v_mfma_scale_f32_16x16x128_f8f6f4 %0, %1, %2, %0, %3, %3 op_sel_hi:[0,0,0]" : "+v"(acc[ai][bj][m][n]) : "v"(Bt##8[n]), "v"(At##8[m]), "v"(fp8_one)); \
        else { _Pragma("unroll") for (int k = 0; k < 2; ++k) acc[ai][bj][m][n] = __builtin_amdgcn_mfma_f32_16x16x32_bf16(Bt[n][k], At[m][k], acc[ai][bj][m][n], 0, 0, 0); } } __builtin_amdgcn_s_setprio(0); if constexpr (FP8) __builtin_amdgcn_sched_barrier(0); } while (0)
#define PG8_WAIT_V(n) asm volatile("s_waitcnt vmcnt(" #n ")" ::: "memory")
#define PG8_WAIT_L(n) asm volatile("s_waitcnt lgkmcnt(" #n ")" ::: "memory")
#define PG8_BAR __builtin_amdgcn_s_barrier()
#define PG8_SCHED __builtin_amdgcn_sched_barrier(0)
    Unit cur, nxt; int ui = 0;
    if (!S.next(0, cur)) return;
    f32x4 acc[2][2][4][2];
#pragma unroll
    for (int a = 0; a < 2; ++a)
#pragma unroll
        for (int b = 0; b < 2; ++b)
#pragma unroll
            for (int m = 0; m < 4; ++m)
#pragma unroll
                for (int n = 0; n < 2; ++n) acc[a][b][m][n] = (f32x4){0.f, 0.f, 0.f, 0.f};
    bf16x8 At[4][2], B0[2][2], B1[2][2];
    const int fp8_one = 0x7f7f7f7f;
    i32x8 At8[4], B08[2], B18[2];
    const char* cA = cur.a; const char* cB = cur.b;
    S.a_ready(cur);
    if constexpr (SP2) {
        PG8_STAGE(PG8_SB(0, 0), cB, voffB); PG8_STAGE(PG8_SB(0, 1), cB + hstep, voffB); PG8_STAGE(PG8_SA(0, 0), cA, voffA); PG8_STAGE(PG8_SA(0, 1), cA + hstep, voffA);
        if (wr == 1) PG8_BAR;
        PG8_WAIT_V(2); PG8_BAR;
        PG8_STAGE(PG8_SB(1, 0), cB + kstep, voffB); PG8_STAGE(PG8_SA(1, 0), cA + kstep, voffA); PG8_STAGE(PG8_SB(1, 1), cB + hstep + kstep, voffB);
        PG8_WAIT_V(6); PG8_BAR;
    } else {
        PG8_STAGE(PG8_SB(0, 0), cB, voffB); PG8_STAGE(PG8_SA(0, 0), cA, voffA); PG8_STAGE(PG8_SB(0, 1), cB + hstep, voffB); PG8_STAGE(PG8_SA(0, 1), cA + hstep, voffA);
        if (wr == 1) PG8_BAR;
        PG8_WAIT_V(4); PG8_BAR;
        PG8_STAGE(PG8_SB(1, 0), cB + kstep, voffB); PG8_STAGE(PG8_SA(1, 0), cA + kstep, voffA); PG8_STAGE(PG8_SB(1, 1), cB + hstep + kstep, voffB);
        PG8_WAIT_V(6); PG8_BAR;
    }
    for (;;) {
        const bool has_next = S.next(ui + 1, nxt);
        const char* nA = has_next ? nxt.a : cA; const char* nB = has_next ? nxt.b : cB;
#pragma nounroll
        for (int t = 0; t < nt; t += 2) {
            const bool last = (t == nt - 2);
            const char* a1 = cA + (size_t)(t + 1) * kstep;
            const char* a2 = last ? nA : cA + (size_t)(t + 2) * kstep; const char* b2 = last ? nB : cB + (size_t)(t + 2) * kstep;
            const char* a3 = a2 + kstep; const char* b3 = b2 + kstep;
            if (last && has_next) S.a_ready(nxt);
            if constexpr (SP2) {
            PG8_LDB(B0, 0, 0); PG8_LDB(B1, 0, 1); PG8_SCHED; PG8_LDA(At, 0, 0); PG8_STAGE(PG8_SA(1, 1), a1 + hstep, voffA);
            PG8_WAIT_V(8); PG8_WAIT_L(0); PG8_BAR; PG8_MMA(0, 0, At, B0); PG8_MMA(0, 1, At, B1); PG8_BAR; PG8_SCHED;
            PG8_LDA(At, 0, 1); PG8_STAGE(PG8_SB(0, 0), b2, voffB); PG8_STAGE(PG8_SB(0, 1), b2 + hstep, voffB); PG8_STAGE(PG8_SA(0, 0), a2, voffA);
            PG8_WAIT_V(8); PG8_WAIT_L(0); PG8_BAR; PG8_MMA(1, 0, At, B0); PG8_MMA(1, 1, At, B1); PG8_BAR; PG8_SCHED;
            PG8_LDB(B0, 1, 0); PG8_LDB(B1, 1, 1); PG8_SCHED; PG8_LDA(At, 1, 0); PG8_STAGE(PG8_SA(0, 1), a2 + hstep, voffA);
            PG8_WAIT_V(8); PG8_WAIT_L(0); PG8_BAR; PG8_MMA(0, 0, At, B0); PG8_MMA(0, 1, At, B1); PG8_BAR; PG8_SCHED;
            PG8_LDA(At, 1, 1); PG8_STAGE(PG8_SB(1, 0), b3, voffB); PG8_STAGE(PG8_SB(1, 1), b3 + hstep, voffB); PG8_STAGE(PG8_SA(1, 0), a3, voffA);
            PG8_WAIT_V(8); PG8_WAIT_L(0); PG8_BAR; PG8_MMA(1, 0, At, B0); PG8_MMA(1, 1, At, B1); PG8_BAR; PG8_SCHED;
            } else {
            PG8_LDB(B0, 0, 0); PG8_SCHED; PG8_LDA(At, 0, 0); PG8_STAGE(PG8_SA(1, 1), a1 + hstep, voffA);
            PG8_WAIT_L(8); PG8_BAR; PG8_WAIT_L(0); PG8_MMA(0, 0, At, B0); PG8_BAR; PG8_SCHED;
            PG8_LDB(B1, 0, 1); PG8_STAGE(PG8_SB(0, 0), b2, voffB);
            PG8_BAR; PG8_WAIT_L(0); PG8_MMA(0, 1, At, B1); PG8_BAR;
            PG8_LDA(At, 0, 1); PG8_STAGE(PG8_SA(0, 0), a2, voffA);
            PG8_BAR; PG8_WAIT_L(0); PG8_MMA(1, 0, At, B0); PG8_BAR; PG8_SCHED;
            PG8_STAGE(PG8_SB(0, 1), b2 + hstep, voffB);
            PG8_WAIT_V(6); PG8_BAR; PG8_MMA(1, 1, At, B1); PG8_BAR;
            PG8_LDB(B0, 1, 0); PG8_SCHED; PG8_LDA(At, 1, 0); PG8_STAGE(PG8_SA(0, 1), a2 + hstep, voffA);
            PG8_WAIT_L(8); PG8_BAR; PG8_WAIT_L(0); PG8_MMA(0, 0, At, B0); PG8_BAR; PG8_SCHED;
            PG8_LDB(B1, 1, 1); PG8_STAGE(PG8_SB(1, 0), b3, voffB);
            PG8_BAR; PG8_WAIT_L(0); PG8_MMA(0, 1, At, B1); PG8_BAR;
            PG8_LDA(At, 1, 1); PG8_STAGE(PG8_SA(1, 0), a3, voffA);
            PG8_BAR; PG8_WAIT_L(0); PG8_MMA(1, 0, At, B0); PG8_BAR; PG8_SCHED;
            PG8_STAGE(PG8_SB(1, 1), b3 + hstep, voffB);
            PG8_WAIT_V(6); PG8_BAR; PG8_MMA(1, 1, At, B1); PG8_BAR;
            }
        }
        if constexpr (FP8) asm volatile("s_nop 15\n\ts_nop 15" ::: "memory");
        if constexpr (ALIGN_EPI) { if (wr == 0) PG8_BAR; }
        if constexpr (!Epi::AFTER_DRAIN) { if (!(xflags & 1)) E(acc, cur, wr, wc, fr, fq); S.done(cur); }
        if (!has_next) break;
        bool keep_acc = false; if constexpr (Epi::KEEPS) keep_acc = E.keep(cur);
        if (!keep_acc) {
#pragma unroll
        for (int a = 0; a < 2; ++a)
#pragma unroll
            for (int b = 0; b < 2; ++b)
#pragma unroll
                for (int m = 0; m < 4; ++m)
#pragma unroll
                    for (int n = 0; n < 2; ++n) acc[a][b][m][n] = (f32x4){0.f, 0.f, 0.f, 0.f};
        }
        cur = nxt; cA = nA; cB = nB; ++ui;
        if constexpr (ALIGN_EPI) { if (wr == 1) PG8_BAR; }
    }
    PG8_WAIT_V(0);
    if constexpr (!ALIGN_EPI) { if (wr == 0) PG8_BAR; }
    PG8_BAR;
    if constexpr (Epi::AFTER_DRAIN) { E.fused(acc, cur, wr, wc, fr, fq, lds, wid, lane); S.done(cur); }
#undef PG8_SA
#undef PG8_SB
#undef PG8_STAGE
#undef PG8_LDA
#undef PG8_LDB
#undef PG8_MMA
#undef PG8_WAIT_V
#undef PG8_WAIT_L
#undef PG8_BAR
#undef PG8_SCHED
}

}
#ifndef XR16
#define XR16 1
#endif
#ifndef DFT1_FP8
#define DFT1_FP8 1
#endif
#ifndef INPROJ1_FP8
#define INPROJ1_FP8 1
#endif
constexpr int NWAVES = 8;
constexpr int D = 1024, NB = 8, S = 2048, T = NB * S;
constexpr int DIN = 3584, NIN = 4096;
constexpr int FFD = 2816, FFE = 3584, NE = 8;
constexpr int XG_ROWS = 2 * T + NE * 256, NT_MAX = XG_ROWS / 256;
constexpr int CHUNK_TILES = 64;
constexpr float RMS_EPS = 1e-6f, LN_EPS = 1e-5f;
constexpr size_t MiB = 1u << 20, KiB = 1024;
constexpr size_t WS_CTL = 0, CTL_ZERO_BYTES = 1 * MiB;
constexpr size_t WS_E12 = 1 * MiB, WS_W12 = WS_E12 + 128 * KiB, WS_POS = WS_W12 + 128 * KiB, WS_WGCNT = WS_POS + 128 * KiB, WS_TEXP = WS_WGCNT + 8 * KiB, WS_WSB = WS_E12 + 512 * KiB;
constexpr size_t WS_MW13 = 4 * MiB, WS_MW2 = 60 * MiB;
constexpr size_t WS_WIN = 88 * MiB, WS_WF = 104 * MiB, WS_WG = 106 * MiB, WS_WOUT = 108 * MiB;
constexpr size_t WS_DW13 = 112 * MiB, WS_DW2 = 123 * MiB;
constexpr size_t WS_DFT = 129 * MiB;
constexpr size_t WS_XN = 145 * MiB;
constexpr size_t WS_PQT = 177 * MiB, WS_MM = WS_PQT;
constexpr size_t WS_GU = 209 * MiB, WS_GV = 225 * MiB;
constexpr size_t WS_G0 = 241 * MiB, WS_G1 = 273 * MiB, WS_Y = WS_G0;
constexpr size_t WS_FA = 305 * MiB, WS_SG = 337 * MiB;
constexpr size_t WS_HD = 177 * MiB, WS_YD = 265 * MiB;
constexpr size_t WS_XG = 177 * MiB, WS_HM = 211 * MiB, WS_HM2 = 274 * MiB, WS_YG = 330 * MiB;
constexpr size_t WS_DFT8 = 398 * MiB;
constexpr size_t WS_XR = 406 * MiB;
constexpr size_t WS_END = 438 * MiB;
constexpr float ACT_SCALE = 16.f, W13_SCALE = 64.f, W2_SCALE = 128.f, PQ_SCALE = 4.f, DFT_SCALE = 32768.f;
static_assert(WS_HM + (size_t)(NT_MAX - CHUNK_TILES) * 256 * FFE <= WS_HM2 && WS_HM2 + (size_t)CHUNK_TILES * 256 * FFE <= WS_YG && WS_YG + (size_t)XG_ROWS * D * 2 <= WS_DFT8 && WS_XG + (size_t)XG_ROWS * D <= WS_HM, "d_ws map");
constexpr int CW_TMO = 0, CW_CODE = 1, CW_NTILES = 16, CW_BAR = 4096;
constexpr int RING_BYTES = 131072;
constexpr int LDS_MISC = 139264, LDS_TEXP = LDS_MISC + 256, LDS_BYTES = 147456;
#define GAS __attribute__((address_space(1)))
#define LAS __attribute__((address_space(3)))
typedef unsigned short bf16;
typedef unsigned v4u __attribute__((ext_vector_type(4)));
typedef unsigned v2u __attribute__((ext_vector_type(2)));
typedef float f32x4 __attribute__((ext_vector_type(4)));
typedef short bf16x8 __attribute__((ext_vector_type(8)));
typedef GAS unsigned gu32;
#define RLX_AGENT __ATOMIC_RELAXED, __HIP_MEMORY_SCOPE_AGENT
#define LDS_WAIT() asm volatile("s_waitcnt lgkmcnt(0)" ::: "memory")
#define VM_WAIT() asm volatile("s_waitcnt vmcnt(0)" ::: "memory")
__device__ __forceinline__ unsigned pk2(float lo, float hi) { return pg8::cvt_pk_bf16(lo, hi); }
__device__ __forceinline__ float bflo(unsigned w) { return __uint_as_float(w << 16); }
__device__ __forceinline__ float bfhi(unsigned w) { return __uint_as_float(w & 0xffff0000u); }
__device__ __forceinline__ float wave_sum(float v) {
#pragma unroll
    for (int o = 1; o < 64; o <<= 1) v += __shfl_xor(v, o);
    return v;
}
#define XB_TMO      128
#define XB_XCNT(j)  (256  + 64 * (j))
#define XB_XSUB(j)  (1280 + 64 * (j))
#define XB_XGEN(j)  (2304 + 64 * (j))
#define XB_TOP      3328
#define XB_TOPGEN   3392
#define XCD_BAR_WORDS 3456
#define XB_SPIN_CAP (1u << 18)

__device__ __forceinline__ unsigned xb_ld(unsigned* p)              { return __hip_atomic_load(p, __ATOMIC_RELAXED, __HIP_MEMORY_SCOPE_AGENT); }
__device__ __forceinline__ unsigned xb_add(unsigned* p, unsigned v) { return __hip_atomic_fetch_add(p, v, __ATOMIC_RELAXED, __HIP_MEMORY_SCOPE_AGENT); }
__device__ __forceinline__ unsigned xb_xcc_id() { return (unsigned)__builtin_amdgcn_s_getreg((3 << 11) | 20) & 0xFu; }
#define XB_SPIN(cond, bar) do { unsigned _sp = 0; while (cond) { __builtin_amdgcn_s_sleep(1); \
    if ((++_sp & 255u) == 0u) { if (xb_ld(&(bar)[XB_TMO])) break; if (_sp > XB_SPIN_CAP) { atomicAdd(&(bar)[XB_TMO], 1u); break; } } } } while (0)

struct XcdBarrier {
    unsigned* bar; unsigned x;
    volatile LAS unsigned* st;
};

__device__ __forceinline__ XcdBarrier xcd_barrier_post(unsigned* bar, volatile LAS unsigned* st) {
    XcdBarrier b; b.bar = bar; b.x = xb_xcc_id(); b.st = st;
    if (threadIdx.x == 0) (void)xb_add(&bar[XB_XCNT(b.x)], 1u);
    return b;
}
__device__ __forceinline__ void xcd_barrier_complete(unsigned* bar, unsigned x, unsigned& nloc, unsigned& nx) {
    const unsigned G = gridDim.x * gridDim.y * gridDim.z;
    unsigned sum, cnt, mine, sp = 0u;
    for (;;) {
        sum = 0u; cnt = 0u; mine = 0u;
#pragma unroll
        for (unsigned j = 0; j < 16; ++j) { const unsigned c = xb_ld(&bar[XB_XCNT(j)]); sum += c; cnt += (c > 0u) ? 1u : 0u; mine = (j == x) ? c : mine; }
        if (sum == G) break;
        __builtin_amdgcn_s_sleep(1);
        if ((++sp & 255u) == 0u) { if (xb_ld(&bar[XB_TMO])) break; if (sp > XB_SPIN_CAP) { atomicAdd(&bar[XB_TMO], 1u); break; } }
    }
    nloc = mine > 0u ? mine : 1u; nx = cnt > 0u ? cnt : 1u;
}

__device__ __forceinline__ void xcd_barrier(const XcdBarrier& b) {
    asm volatile("s_waitcnt vmcnt(0)" ::: "memory");
    __syncthreads();
    if (threadIdx.x == 0) {
        unsigned* bar = b.bar;
        __builtin_amdgcn_s_waitcnt(0);
        unsigned nloc = b.st[0], nx = b.st[1];
        if (nloc == 0u) { xcd_barrier_complete(bar, b.x, nloc, nx); b.st[0] = nloc; b.st[1] = nx; }
        const unsigned old = xb_add(&bar[XB_XSUB(b.x)], 1u);
        const unsigned gen = old / nloc;
        if (old + 1u == (gen + 1u) * nloc) {
            __builtin_amdgcn_fence(__ATOMIC_RELEASE, "agent");
            asm volatile("s_waitcnt vmcnt(0)" ::: "memory");
            const unsigned og = xb_add(&bar[XB_TOP], 1u);
            const unsigned tg = og / nx;
            if (og + 1u == (tg + 1u) * nx) xb_add(&bar[XB_TOPGEN], 1u);
            else XB_SPIN(xb_ld(&bar[XB_TOPGEN]) == tg, bar);
            __builtin_amdgcn_fence(__ATOMIC_ACQUIRE, "agent");
            xb_add(&bar[XB_XGEN(b.x)], 1u);
            asm volatile("s_waitcnt vmcnt(0)" ::: "memory");
        } else {
            XB_SPIN(xb_ld(&bar[XB_XGEN(b.x)]) == gen, bar);
            __builtin_amdgcn_fence(__ATOMIC_ACQUIRE, "agent");
            asm volatile("s_waitcnt vmcnt(0)" ::: "memory");
        }
    }
    __syncthreads();
}

__device__ __forceinline__ void tr_item(const float* __restrict__ W, int ldw, bf16* __restrict__ WT, int ldt, int k0, int n0, int drow0, LAS unsigned* scr, int lane) {
    const int n4 = (lane & 15) * 4, kq = lane >> 4;
    const float* src = W + (size_t)(k0 + 2 * kq) * ldw + n0 + n4;
    f32x4 v0[16], v1[16];
#pragma unroll
    for (int it = 0; it < 16; ++it) { const float* p = src + (size_t)(it * 8) * ldw; v0[it] = __builtin_nontemporal_load((const f32x4*)p); v1[it] = __builtin_nontemporal_load((const f32x4*)(p + ldw)); }
#pragma unroll
    for (int it = 0; it < 16; ++it) { const int kp = it * 4 + kq;
#pragma unroll
        for (int i = 0; i < 4; ++i) scr[(n4 + i) * 66 + kp] = pk2(v0[it][i], v1[it][i]); }
    LDS_WAIT(); asm volatile("" ::: "memory");
    const int c = lane & 15;
#pragma unroll
    for (int r = 0; r < 16; ++r) { const int j = (lane >> 4) + 4 * r; const LAS v2u* s = (const LAS v2u*)(scr + j * 66 + 4 * c);
        const v2u a = s[0], b = s[1]; v4u o; o.x = a.x; o.y = a.y; o.z = b.x; o.w = b.y;
        __builtin_nontemporal_store(o, (GAS v4u*)(WT + (size_t)(drow0 + j) * ldt + k0 + 8 * c)); }
    LDS_WAIT(); asm volatile("" ::: "memory");
}
__device__ __forceinline__ void tr_item8(const float* __restrict__ W, int ldw, unsigned char* __restrict__ WT, int ldt, int k0, int n0, int drow0, float scale, LAS unsigned* scr, int lane) {
    const int n4 = (lane & 15) * 4, kq = lane >> 4;
    f32x4 v[2][4][4];
#pragma unroll
    for (int hh = 0; hh < 2; ++hh)
#pragma unroll
        for (int it = 0; it < 4; ++it)
#pragma unroll
            for (int rr = 0; rr < 4; ++rr) v[hh][it][rr] = __builtin_nontemporal_load((const f32x4*)(W + (size_t)(k0 + hh * 64 + (it * 4 + kq) * 4 + rr) * ldw + n0 + n4));
#pragma unroll
    for (int hh = 0; hh < 2; ++hh)
#pragma unroll
        for (int it = 0; it < 4; ++it) { const int kw = hh * 16 + it * 4 + kq;
#pragma unroll
            for (int i = 0; i < 4; ++i) scr[(n4 + i) * 34 + kw] = pg8::pack4_fp8(v[hh][it][0][i] * scale, v[hh][it][1][i] * scale, v[hh][it][2][i] * scale, v[hh][it][3][i] * scale); }
    LDS_WAIT(); asm volatile("" ::: "memory");
    const int c = lane & 7;
#pragma unroll
    for (int r = 0; r < 8; ++r) { const int j = (lane >> 3) + 8 * r; const LAS v2u* sp = (const LAS v2u*)(scr + j * 34 + 4 * c);
        const v2u a = sp[0], b = sp[1]; v4u o; o.x = a.x; o.y = a.y; o.z = b.x; o.w = b.y;
        __builtin_nontemporal_store(o, (GAS v4u*)(WT + (size_t)(drow0 + j) * ldt + k0 + 16 * c)); }
    LDS_WAIT(); asm volatile("" ::: "memory");
}
struct Args { const float* in[21]; float* out; unsigned char* ws; int ph_lo, ph_hi, flags, pad; };
typedef const __attribute__((address_space(4))) Args* ArgsP;
__device__ __forceinline__ ArgsP kargs() { ArgsP p = (ArgsP)__builtin_amdgcn_kernarg_segment_ptr(); asm volatile("" : "+s"(p)); return p; }

template <int WHICH>
__device__ __forceinline__ void convert_weights(ArgsP io, LAS unsigned char* lds, int lane, int wave, int gw, int NGW) {
    unsigned char* ws = io->ws;
    const float* w_in = io->in[3];
    LAS unsigned* scr = (LAS unsigned*)(lds + wave * 16896);
    constexpr int IT_IN = 8 * 48, IT_F = 4 * 16, IT_O = 8 * 16, IT_D13 = 8 * 44, IT_D2 = 22 * 16, IT_M13 = 8 * 56, IT_M2 = 28 * 16;
    constexpr int NITEMS = WHICH == 1 ? NE * (2 * IT_M13 + IT_M2) : (WHICH == 3 ? 2 * IT_D13 : IT_IN + 2 * IT_F + IT_O + (WHICH == 2 ? IT_D2 : 0));
    for (int it = gw; it < NITEMS; it += NGW) {
        int r = it; const float* W = nullptr; bf16* WT = nullptr; int ldw = 0, ldt = 0, nnb = 1, mode = 0, roff = 0; float f8 = 0.f; bool found = false;
#define TR_ENTRY8(W_, K_, N_, ldw_, WT_, ldt_, mode_, roff_, f8_) if (!found) { const int nit_ = ((K_) / 128) * ((N_) / 64); if (r < nit_) { W = (W_); ldw = (ldw_); WT = (bf16*)(WT_); ldt = (ldt_); nnb = (N_) / 64; mode = (mode_); roff = (roff_); f8 = (f8_); found = true; } else r -= nit_; }
#define TR_ENTRY(W_, K_, N_, ldw_, WT_, ldt_, mode_, roff_) TR_ENTRY8(W_, K_, N_, ldw_, WT_, ldt_, mode_, roff_, 0.f)
        if (WHICH == 1) for (int e = 0; e < NE; ++e) {
            TR_ENTRY8(io->in[18] + (size_t)e * D * FFE, D, FFE, FFE, ws + WS_MW13 + (size_t)e * 2 * FFE * D, D, 1, 0, W13_SCALE)
            TR_ENTRY8(io->in[19] + (size_t)e * D * FFE, D, FFE, FFE, ws + WS_MW13 + (size_t)e * 2 * FFE * D, D, 1, 128, W13_SCALE)
            TR_ENTRY8(io->in[20] + (size_t)e * FFE * D, FFE, D, D, ws + WS_MW2 + (size_t)e * D * FFE, FFE, 0, 0, W2_SCALE)
        }
        if (WHICH == 0 || WHICH == 2) { const int l = WHICH == 2 ? 1 : 0;
            const float f8in = (INPROJ1_FP8 && WHICH == 2) ? W13_SCALE : 0.f;
            TR_ENTRY8(w_in + (size_t)l * D * DIN + 512, D, 1024, DIN, ws + WS_WIN + (size_t)l * NIN * D * 2, D, 0, 1024, f8in)
            TR_ENTRY8(w_in + (size_t)l * D * DIN + 1536, D, 1024, DIN, ws + WS_WIN + (size_t)l * NIN * D * 2, D, 1, 2048, f8in)
            TR_ENTRY8(w_in + (size_t)l * D * DIN + 2560, D, 1024, DIN, ws + WS_WIN + (size_t)l * NIN * D * 2, D, 1, 2048 + 128, f8in)
            TR_ENTRY(io->in[4] + (size_t)l * 512 * D, 512, D, D, (bf16*)(ws + WS_WF) + (size_t)l * D * 512, 512, 0, 0)
            TR_ENTRY(io->in[5] + (size_t)l * 512 * D, 512, D, D, (bf16*)(ws + WS_WG) + (size_t)l * D * 512, 512, 0, 0)
            TR_ENTRY(io->in[6] + (size_t)l * D * D, D, D, D, (bf16*)(ws + WS_WOUT) + (size_t)l * D * D, D, 0, 0)
        }
        if (WHICH == 3) {
        TR_ENTRY(io->in[13], D, FFD, FFD, (bf16*)(ws + WS_DW13), D, 1, 0)
        TR_ENTRY(io->in[14], D, FFD, FFD, (bf16*)(ws + WS_DW13), D, 1, 128)
        }
        if (WHICH == 2) { TR_ENTRY(io->in[15], FFD, D, D, (bf16*)(ws + WS_DW2), FFD, 0, 0) }
#undef TR_ENTRY
#undef TR_ENTRY8
        const int nb = r % nnb, kb = r / nnb, n0 = nb * 64; const int drow = mode ? 256 * (n0 >> 7) + roff + (n0 & 127) : roff + n0;
        if (f8 != 0.f) tr_item8(W, ldw, (unsigned char*)WT, ldt, kb * 128, n0, drow, f8, scr, lane); else tr_item(W, ldw, WT, ldt, kb * 128, n0, drow, scr, lane);
    }
}
__device__ __forceinline__ void fold_inproj(ArgsP io, LAS unsigned char* lds, int tid, int l, int wg, int nwg) {
    unsigned char* ws = io->ws; const float* w_in = io->in[3];
    LAS float* za = (LAS float*)lds;
    LAS float* tc = (LAS float*)(lds + 16384);
    __syncthreads();
    if (tid < 128) { tc[tid] = cospif((float)tid * (2.0f / 128.0f)); tc[128 + tid] = sinpif((float)tid * (2.0f / 128.0f)); }
    for (int item = wg; item < 256; item += nwg) {
        const int d0 = (item >> 1) * 8, h2 = item & 1;
        __syncthreads();
        { const int rr = tid >> 6, c4 = (tid & 63) * 4; *(LAS f32x4*)(za + rr * 256 + c4) = *(const f32x4*)(w_in + ((size_t)l * D + d0 + rr) * DIN + h2 * 256 + c4); }
        __syncthreads();
        { const int cc = tid + h2 * 512, pq = cc & 1, j = (cc >> 1) & 127, g = (cc >> 8) & 1;
            float acc[8];
#pragma unroll
            for (int rr = 0; rr < 8; ++rr) acc[rr] = 0.f;
            const LAS float* tb = tc + pq * 128; const LAS float* zg = za + g * 128;
            for (int c = 0; c < 128; c += 4) { const float w0 = tb[(j * c) & 127], w1 = tb[(j * (c + 1)) & 127], w2 = tb[(j * (c + 2)) & 127], w3 = tb[(j * (c + 3)) & 127];
#pragma unroll
                for (int rr = 0; rr < 8; ++rr) { const f32x4 z = *(const LAS f32x4*)(zg + rr * 256 + c); acc[rr] += (z[0] * w0 + z[1] * w1) + (z[2] * w2 + z[3] * w3); } }
            if (INPROJ1_FP8 && l == 1) { v2u o8; o8.x = pg8::pack4_fp8(acc[0] * W13_SCALE, acc[1] * W13_SCALE, acc[2] * W13_SCALE, acc[3] * W13_SCALE); o8.y = pg8::pack4_fp8(acc[4] * W13_SCALE, acc[5] * W13_SCALE, acc[6] * W13_SCALE, acc[7] * W13_SCALE);
                *(GAS v2u*)(ws + WS_WIN + (size_t)l * NIN * D * 2 + (size_t)cc * D + d0) = o8; }
            else { v4u o; o.x = pk2(acc[0], acc[1]); o.y = pk2(acc[2], acc[3]); o.z = pk2(acc[4], acc[5]); o.w = pk2(acc[6], acc[7]);
                *(GAS v4u*)((bf16*)(ws + WS_WIN) + ((size_t)l * NIN + cc) * D + d0) = o; } }
    }
    __syncthreads();
}
__device__ __forceinline__ void p0_prologue(ArgsP io, LAS unsigned char* lds, int tid, int lane, int wave, int vcu, int G) {
    unsigned char* ws = io->ws;
    const float* w_in = io->in[3];
    LAS unsigned* scr = (LAS unsigned*)(lds + wave * 16896);
    const int gw = wave * G + vcu, NGW = G * NWAVES;
    convert_weights<0>(io, lds, lane, wave, gw, NGW);
    __syncthreads();
    fold_inproj(io, lds, tid, 0, blockIdx.x, G);
    {
        LAS float* cosT = (LAS float*)(lds + 32768);
        for (int m = tid; m < 2048; m += NWAVES * 64) cosT[m] = cospif((float)m * (2.0f / 2048.0f)) * (1.0f / 512.0f);
        __syncthreads();
        for (int i = vcu * (NWAVES * 64) + tid; i < 2048 * 512; i += G * NWAVES * 64) { const int k = i >> 9, s0 = (i & 511) * 8; float v[8];
#pragma unroll
            for (int q = 0; q < 8; ++q) { const int sp = s0 + q; v[q] = sp < 2048 ? cosT[(k * sp) & 2047] : -cosT[(k * (sp - 2048) - 512) & 2047]; }
            v4u o; o.x = pk2(v[0], v[1]); o.y = pk2(v[2], v[3]); o.z = pk2(v[4], v[5]); o.w = pk2(v[6], v[7]);
            *(GAS v4u*)((bf16*)(ws + WS_DFT) + (size_t)k * 4096 + s0) = o;
            if (DFT1_FP8) { v2u o8; o8.x = pg8::pack4_fp8(v[0] * DFT_SCALE, v[1] * DFT_SCALE, v[2] * DFT_SCALE, v[3] * DFT_SCALE); o8.y = pg8::pack4_fp8(v[4] * DFT_SCALE, v[5] * DFT_SCALE, v[6] * DFT_SCALE, v[7] * DFT_SCALE);
                *(GAS v2u*)(ws + WS_DFT8 + (size_t)k * 4096 + s0) = o8; } }
    }
    for (int i = vcu * (NWAVES * 64) + tid; i < 2 * 4 * 128 * 128 / 8; i += G * NWAVES * 64) { const f32x4 a = *(const f32x4*)(io->in[7] + (size_t)i * 8), b = *(const f32x4*)(io->in[7] + (size_t)i * 8 + 4);
        v4u o; o.x = pk2(a[0], a[1]); o.y = pk2(a[2], a[3]); o.z = pk2(b[0], b[1]); o.w = pk2(b[2], b[3]); *(GAS v4u*)((bf16*)(ws + WS_WSB) + (size_t)i * 8) = o; }
}

__device__ __forceinline__ void load_row4(const float* row, int lane, f32x4 (&v)[4]) {
    const GAS f32x4* p = (const GAS f32x4*)row + lane;
#pragma unroll
    for (int j = 0; j < 4; ++j) v[j] = p[64 * j];
}
__device__ __forceinline__ void load_row4_nt(const float* row, int lane, f32x4 (&v)[4]) {
    const GAS f32x4* p = (const GAS f32x4*)row + lane;
#pragma unroll
    for (int j = 0; j < 4; ++j) v[j] = __builtin_nontemporal_load(p + 64 * j);
}
__device__ __forceinline__ float sumsq4(const f32x4 (&v)[4]) { float s = 0.f;
#pragma unroll
    for (int j = 0; j < 4; ++j) s += (v[j].x * v[j].x + v[j].y * v[j].y) + (v[j].z * v[j].z + v[j].w * v[j].w);
    return s; }
__device__ __forceinline__ void store_row_bf16(bf16* orow, int lane, const f32x4 (&v)[4]) {
    GAS v2u* o8 = (GAS v2u*)orow + lane;
#pragma unroll
    for (int j = 0; j < 4; ++j) { v2u w; w.x = pk2(v[j].x, v[j].y); w.y = pk2(v[j].z, v[j].w); o8[64 * j] = w; }
}
__device__ __forceinline__ void norm_rows(const float* x, const float* g, bf16* XN, int lane, int wave) {
    const int row0 = blockIdx.x * 64 + wave * 8;
    f32x4 gg[4]; load_row4(g, lane, gg);
#pragma unroll
    for (int h = 0; h < 2; ++h) {
        f32x4 v[4][4];
#pragma unroll
        for (int i = 0; i < 4; ++i) load_row4_nt(x + (size_t)(row0 + h * 4 + i) * D, lane, v[i]);
#pragma unroll
        for (int i = 0; i < 4; ++i) { const float r = 1.0f / sqrtf(wave_sum(sumsq4(v[i])) * (1.0f / D) + RMS_EPS);
#pragma unroll
            for (int j = 0; j < 4; ++j) v[i][j] = v[i][j] * r * gg[j];
            store_row_bf16(XN + (size_t)(row0 + h * 4 + i) * D, lane, v[i]); }
    }
}
#ifndef COMB_ROWS
#define COMB_ROWS 4
#endif
template <int MODE, bool ROUTE, bool XN8 = false, bool XI16 = false, bool XO16 = false, int R = (MODE == 1 ? COMB_ROWS : (ROUTE ? 2 : 4))>
__device__ __forceinline__ void post_rows(ArgsP io, LAS unsigned char* lds, const bf16* Y, const float* xi, float* xo, const float* gpost, const float* gnext, int tid, int lane, int wave) {
    unsigned char* ws = io->ws; bf16* XN = (bf16*)(ws + WS_XN);
    const int row0 = blockIdx.x * 64;
    LAS int* cntL = (LAS int*)(lds + 32768);
    if (ROUTE) { if (tid < 8) cntL[tid] = 0; __syncthreads(); }
    f32x4 gp[4]; load_row4(gpost, lane, gp);
    f32x4 rw[ROUTE ? 32 : 1];
    if (ROUTE) {
        LAS f32x4* rL = (LAS f32x4*)(lds + 65536);
#pragma unroll
        for (int k = 0; k < 4; ++k) { const int g = tid + 512 * k; const int c = g >> 1, L = (c & 255) >> 2;
            rL[(((c >> 8) * 4 + (c & 3)) * 2 + (g & 1)) * 64 + L] = ((const GAS f32x4*)io->in[16])[g]; }
        __syncthreads();
#pragma unroll
        for (int k = 0; k < 32; ++k) rw[k] = rL[k * 64 + lane];
    }
    f32x4 gnv[4]; float rb[ROUTE ? 8 : 1];
    if (gnext) load_row4(gnext, lane, gnv);
    if (ROUTE) {
#pragma unroll
        for (int e = 0; e < 8; ++e) rb[e] = io->in[17][e]; }
    int PP[MODE == 1 ? 16 : 1]; float WW[MODE == 1 ? 16 : 1];
    if (MODE == 1) { const int* pos = (const int*)(ws + WS_POS) + (row0 + wave * 8) * 2; const float* w12 = (const float*)(ws + WS_W12) + (row0 + wave * 8) * 2;
#pragma unroll
        for (int q = 0; q < 16; ++q) { PP[q] = pos[q]; WW[q] = w12[q]; } }
#pragma unroll
    for (int i = 0; i < 8; i += R) {
        f32x4 y[R][4], v[R][4];
#pragma unroll
        for (int u = 0; u < R; ++u) { const int row = row0 + wave * 8 + i + u;
            if (MODE == 0) { const GAS v2u* a = (const GAS v2u*)(Y + (size_t)row * D) + lane;
#pragma unroll
                for (int j = 0; j < 4; ++j) { const v2u ua = __builtin_nontemporal_load(a + 64 * j); y[u][j] = (f32x4){bflo(ua.x), bfhi(ua.x), bflo(ua.y), bfhi(ua.y)}; } }
            else { const bf16* YG = (const bf16*)(ws + WS_YG);
                const int pa = PP[2 * (i + u)], pb = PP[2 * (i + u) + 1]; const float wa = WW[2 * (i + u)], wb = WW[2 * (i + u) + 1];
                const GAS v2u* a = (const GAS v2u*)(YG + (size_t)pa * D) + lane; const GAS v2u* b = (const GAS v2u*)(YG + (size_t)pb * D) + lane;
#pragma unroll
                for (int j = 0; j < 4; ++j) { const v2u ua = __builtin_nontemporal_load(a + 64 * j), ub = __builtin_nontemporal_load(b + 64 * j);
                    y[u][j] = (f32x4){wa * bflo(ua.x) + wb * bflo(ub.x), wa * bfhi(ua.x) + wb * bfhi(ub.x), wa * bflo(ua.y) + wb * bflo(ub.y), wa * bfhi(ua.y) + wb * bfhi(ub.y)}; } }
            if (XI16) { const GAS v2u* a = (const GAS v2u*)((const bf16*)xi + (size_t)row * D) + lane;
#pragma unroll
                for (int j = 0; j < 4; ++j) { const v2u ua = __builtin_nontemporal_load(a + 64 * j); v[u][j] = (f32x4){bflo(ua.x), bfhi(ua.x), bflo(ua.y), bfhi(ua.y)}; } }
            else load_row4_nt(xi + (size_t)row * D, lane, v[u]); }
#pragma unroll
        for (int u = 0; u < R; ++u) { const int row = row0 + wave * 8 + i + u;
            const float r = 1.0f / sqrtf(wave_sum(sumsq4(y[u])) * (1.0f / D) + RMS_EPS);
#pragma unroll
            for (int j = 0; j < 4; ++j) v[u][j] += y[u][j] * r * gp[j];
            if (XO16) { GAS v2u* o = (GAS v2u*)((bf16*)xo + (size_t)row * D) + lane;
#pragma unroll
              for (int j = 0; j < 4; ++j) { v2u w; w.x = pk2(v[u][j].x, v[u][j].y); w.y = pk2(v[u][j].z, v[u][j].w); __builtin_nontemporal_store(w, o + 64 * j); } }
            else { GAS f32x4* o = (GAS f32x4*)(xo + (size_t)row * D) + lane;
#pragma unroll
              for (int j = 0; j < 4; ++j) __builtin_nontemporal_store(v[u][j], o + 64 * j); }
            if (gnext) {
                const float r2 = 1.0f / sqrtf(wave_sum(sumsq4(v[u])) * (1.0f / D) + RMS_EPS);
#pragma unroll
                for (int j = 0; j < 4; ++j) v[u][j] = v[u][j] * r2 * gnv[j];
                if (XN8) { GAS unsigned* o4 = (GAS unsigned*)((unsigned char*)XN + (size_t)row * D) + lane;
#pragma unroll
                    for (int j = 0; j < 4; ++j) o4[64 * j] = pg8::pack4_fp8(v[u][j].x * ACT_SCALE, v[u][j].y * ACT_SCALE, v[u][j].z * ACT_SCALE, v[u][j].w * ACT_SCALE); }
                else store_row_bf16(XN + (size_t)row * D, lane, v[u]);
                if (ROUTE) {
                    float lg[8];
#pragma unroll
                    for (int e = 0; e < 8; ++e) lg[e] = 0.f;
#pragma unroll
                    for (int j = 0; j < 4; ++j)
#pragma unroll
                        for (int q = 0; q < 4; ++q) { const f32x4 r0 = rw[2 * (4 * j + q)], r1 = rw[2 * (4 * j + q) + 1]; const float hv = v[u][j][q];
                            lg[0] += hv * r0.x; lg[1] += hv * r0.y; lg[2] += hv * r0.z; lg[3] += hv * r0.w; lg[4] += hv * r1.x; lg[5] += hv * r1.y; lg[6] += hv * r1.z; lg[7] += hv * r1.w; }
#pragma unroll
                    for (int e = 0; e < 8; ++e) lg[e] = wave_sum(lg[e]) + rb[e];
                    int i1 = 0; float v1 = lg[0];
#pragma unroll
                    for (int e = 1; e < 8; ++e) if (lg[e] > v1) { v1 = lg[e]; i1 = e; }
                    int i2 = -1; float v2 = -INFINITY;
#pragma unroll
                    for (int e = 0; e < 8; ++e) if (e != i1 && lg[e] > v2) { v2 = lg[e]; i2 = e; }
                    if (lane == 0) { const float ex = __expf(v2 - v1), wa = 1.0f / (1.0f + ex); int* e12 = (int*)(ws + WS_E12); float* w12 = (float*)(ws + WS_W12);
                        e12[row * 2] = i1; e12[row * 2 + 1] = i2; w12[row * 2] = wa; w12[row * 2 + 1] = ex * wa;
                        __hip_atomic_fetch_add(cntL + i1, 1, __ATOMIC_RELAXED, __HIP_MEMORY_SCOPE_WORKGROUP); __hip_atomic_fetch_add(cntL + i2, 1, __ATOMIC_RELAXED, __HIP_MEMORY_SCOPE_WORKGROUP); }
                }
            }
        }
    }
    if (ROUTE) { __syncthreads(); if (tid < 8) ((int*)(ws + WS_WGCNT))[blockIdx.x * 8 + tid] = cntL[tid]; }
}
__device__ __forceinline__ void moe_assign(ArgsP io, LAS unsigned char* lds, int tid, int lane, int wave) {
    unsigned char* ws = io->ws; const int G = gridDim.x, me = blockIdx.x;
    LAS int* part = (LAS int*)lds;
    LAS int* offL = part + 64;
    LAS int* baseL = offL + 16;
    LAS int* w0cnt = baseL + 8;
    LAS int* posL = w0cnt + 8;
    const int* wgcnt = (const int*)(ws + WS_WGCNT);
    if (tid < 256) { int c[8];
        if (tid < G) { const int4 a = *(const int4*)(wgcnt + tid * 8), b = *(const int4*)(wgcnt + tid * 8 + 4); c[0] = a.x; c[1] = a.y; c[2] = a.z; c[3] = a.w; c[4] = b.x; c[5] = b.y; c[6] = b.z; c[7] = b.w; }
        else {
#pragma unroll
            for (int e = 0; e < 8; ++e) c[e] = 0; }
#pragma unroll
        for (int e = 0; e < 8; ++e) { int tb = (tid < me) ? c[e] : 0, tt = c[e];
#pragma unroll
            for (int o = 1; o < 64; o <<= 1) { tb += __shfl_xor(tb, o); tt += __shfl_xor(tt, o); }
            if (lane == 0) { part[wave * 16 + e] = tb; part[wave * 16 + 8 + e] = tt; } }
    }
    __syncthreads();
    if (tid == 0) { int off = 0;
        for (int e = 0; e < 8; ++e) { const int tot = part[8 + e] + part[24 + e] + part[40 + e] + part[56 + e]; baseL[e] = part[e] + part[16 + e] + part[32 + e] + part[48 + e]; offL[e] = off; off += (tot + 255) & ~255; }
        offL[8] = off; }
    __syncthreads();
    const int* e12 = (const int*)(ws + WS_E12); int* pos = (int*)(ws + WS_POS);
    if (tid < 128) { const int a = me * 128 + tid; const int e = e12[a]; int rank = 0, cnt_in_w0 = 0;
#pragma unroll
        for (int q = 0; q < 8; ++q) { const unsigned long long m = __ballot(e == q); if (e == q) rank = __popcll(m & ((1ull << lane) - 1ull)); if (wave == 0 && lane == q) cnt_in_w0 = __popcll(m); }
        if (wave == 0 && lane < 8) w0cnt[lane] = cnt_in_w0;
        posL[tid] = rank | (e << 16); }
    __syncthreads();
    if (tid < 128) { const int e = posL[tid] >> 16; const int p = offL[e] + baseL[e] + (posL[tid] & 0xffff) + (tid >= 64 ? w0cnt[e] : 0); pos[me * 128 + tid] = p; posL[tid] = p; }
    __syncthreads();
    const unsigned char* XN = (const unsigned char*)(ws + WS_XN); unsigned char* XG = (unsigned char*)(ws + WS_XG);
    { v4u rowv[16];
#pragma unroll
      for (int q = 0; q < 16; ++q) { const int a = wave + NWAVES * q; const int tok = me * 64 + (a >> 1); rowv[q] = *((const GAS v4u*)(XN + (size_t)tok * D) + lane); }
#pragma unroll
      for (int q = 0; q < 16; ++q) { const int a = wave + NWAVES * q; *((GAS v4u*)(XG + (size_t)posL[a] * D) + lane) = rowv[q]; } }
    if (me == 0) { int* texp = (int*)(ws + WS_TEXP);
        if (tid < NT_MAX) { int te = -1;
#pragma unroll
            for (int e = 0; e < 8; ++e) if (tid * 256 >= offL[e] && tid * 256 < offL[e + 1]) te = e;
            texp[tid] = te; }
        if (tid == 0) ((unsigned*)(ws + WS_CTL))[CW_NTILES] = (unsigned)(offL[8] >> 8); }
}
template <int GPI>
__device__ __forceinline__ void sgu_phase(ArgsP io, LAS unsigned char* lds, int l, int tid, int lane, int wave, int vcu, int G) {
    unsigned char* ws = io->ws;
    const bf16* GU = (const bf16*)(ws + WS_GU); const bf16* GV = (const bf16*)(ws + WS_GV); bf16* SG = (bf16*)(ws + WS_SG);
    const bf16* Wsb = (const bf16*)(ws + WS_WSB) + (size_t)l * 4 * 128 * 128;
    const float* lg = io->in[9] + l * 512; const float* lb = io->in[10] + l * 512; const float* bs = io->in[8] + l * 512;
    LAS bf16* VNT = (LAS bf16*)lds;
    const int q = tid >> 2, sub = tid & 3, fr = lane & 15, fq = lane >> 4;
    for (int it = vcu; it < 512 / GPI; it += G) {
        const int c = it / (4 / GPI), g0 = (it % (4 / GPI)) * GPI, base = c * 128;
        const bf16* vrow = GV + (size_t)(base + q) * 512;
        float s = 0.f, ss = 0.f;
#pragma unroll
        for (int i = 0; i < 16; ++i) { const v4u w = *(const GAS v4u*)(vrow + i * 32 + sub * 8);
            const float a0 = bflo(w.x), a1 = bfhi(w.x), a2 = bflo(w.y), a3 = bfhi(w.y), a4 = bflo(w.z), a5 = bfhi(w.z), a6 = bflo(w.w), a7 = bfhi(w.w);
            s += ((a0 + a1) + (a2 + a3)) + ((a4 + a5) + (a6 + a7)); ss += ((a0 * a0 + a1 * a1) + (a2 * a2 + a3 * a3)) + ((a4 * a4 + a5 * a5) + (a6 * a6 + a7 * a7)); }
        s += __shfl_xor(s, 1); s += __shfl_xor(s, 2); ss += __shfl_xor(ss, 1); ss += __shfl_xor(ss, 2);
        const float mu = s * (1.0f / 512.0f); const float var = fmaxf(ss * (1.0f / 512.0f) - mu * mu, 0.f); const float rs = 1.0f / sqrtf(var + LN_EPS);
        for (int gp = g0; gp < g0 + GPI; gp += 2) {
        const int p = 16 * wave + fr;
        bf16x8 wa[2][4]; float bias[2]; v2u uw[2][8];
#pragma unroll
        for (int gg = 0; gg < 2; ++gg) { const int g = gp + gg;
            const bf16* wrow = Wsb + ((size_t)g * 128 + p) * 128 + 8 * fq;
#pragma unroll
            for (int ks = 0; ks < 4; ++ks) wa[gg][ks] = *(const GAS bf16x8*)(wrow + 32 * ks);
            bias[gg] = bs[g * 128 + p];
            const size_t ro = (size_t)(base + p) * 512 + g * 128 + 4 * fq;
#pragma unroll
            for (int nt = 0; nt < 8; ++nt) uw[gg][nt] = *(const GAS v2u*)(GU + ro + 16 * nt); }
        __syncthreads();
#pragma unroll
        for (int gg = 0; gg < 2; ++gg) { const int g = gp + gg; LAS bf16* V = VNT + gg * (128 * 136);
#pragma unroll
        for (int i = 0; i < 4; ++i) { const int d0 = sub * 32 + i * 8; const v4u w = *(const GAS v4u*)(vrow + g * 128 + d0);
            const f32x4 ga = *(const f32x4*)(lg + g * 128 + d0), gb = *(const f32x4*)(lg + g * 128 + d0 + 4), ba = *(const f32x4*)(lb + g * 128 + d0), bb = *(const f32x4*)(lb + g * 128 + d0 + 4);
            float o[8] = {bflo(w.x), bfhi(w.x), bflo(w.y), bfhi(w.y), bflo(w.z), bfhi(w.z), bflo(w.w), bfhi(w.w)};
            const float gv[8] = {ga[0], ga[1], ga[2], ga[3], gb[0], gb[1], gb[2], gb[3]}; const float bbv[8] = {ba[0], ba[1], ba[2], ba[3], bb[0], bb[1], bb[2], bb[3]};
#pragma unroll
            for (int k = 0; k < 8; k += 2) { const unsigned pw = pk2((o[k] - mu) * rs * gv[k] + bbv[k], (o[k + 1] - mu) * rs * gv[k + 1] + bbv[k + 1]);
                V[(d0 + k) * 136 + q] = (bf16)(pw & 0xffffu); V[(d0 + k + 1) * 136 + q] = (bf16)(pw >> 16); } } }
        __syncthreads();
#pragma unroll
        for (int gg = 0; gg < 2; ++gg) { const int g = gp + gg; const LAS bf16* V = VNT + gg * (128 * 136);
        f32x4 acc[8];
#pragma unroll
        for (int nt = 0; nt < 8; ++nt) acc[nt] = (f32x4){0.f, 0.f, 0.f, 0.f};
#pragma unroll
        for (int ks = 0; ks < 4; ++ks) {
#pragma unroll
            for (int nt = 0; nt < 8; ++nt) { const bf16x8 b = *(const LAS bf16x8*)(V + (16 * nt + fr) * 136 + 32 * ks + 8 * fq); acc[nt] = __builtin_amdgcn_mfma_f32_16x16x32_bf16(b, wa[gg][ks], acc[nt], 0, 0, 0); } }
        const size_t ro = (size_t)(base + p) * 512 + g * 128 + 4 * fq;
#pragma unroll
        for (int nt = 0; nt < 8; ++nt) { const v2u u2 = uw[gg][nt];
            v2u o; o.x = pk2(bflo(u2.x) * (acc[nt][0] + bias[gg]), bfhi(u2.x) * (acc[nt][1] + bias[gg])); o.y = pk2(bflo(u2.y) * (acc[nt][2] + bias[gg]), bfhi(u2.y) * (acc[nt][3] + bias[gg]));
            *(GAS v2u*)(SG + ro + 16 * nt) = o; } }
        }
    }
    __syncthreads();
}
#ifndef GP_ALIGN
#define GP_ALIGN true
#endif
#ifndef GP_SP2
#define GP_SP2 true
#endif
constexpr int N_PHASES = 19;
__global__ void __launch_bounds__(NWAVES * 64, 2) mega_fwd(Args args) {
    extern __shared__ __attribute__((aligned(16))) unsigned char lds_raw[];
    LAS unsigned char* lds = (LAS unsigned char*)lds_raw;
    volatile LAS unsigned* MISC = (volatile LAS unsigned*)(lds + LDS_MISC);
#define PH_IDS int tid = threadIdx.x; asm volatile("" : "+v"(tid)); const int lane = tid & 63, wave = __builtin_amdgcn_readfirstlane(tid >> 6); (void)lane; (void)wave;
#define PH_GRID int bx = blockIdx.x, G = gridDim.x; asm volatile("" : "+s"(bx), "+s"(G)); const int vcu = (G % 8 == 0) ? (bx % 8) * (G / 8) + bx / 8 : bx; (void)vcu;
    unsigned char* ws0 = kargs()->ws;
#define XFLAGS (io->flags)
#define PH_WS const ArgsP io = kargs(); unsigned char* ws = io->ws;
    gu32* ctl = (gu32*)(ws0 + WS_CTL);
    for (int u = threadIdx.x; u < (LDS_BYTES - LDS_MISC) / 4; u += NWAVES * 64) ((LAS unsigned*)(lds + LDS_MISC))[u] = 0u;
    __syncthreads();
    XcdBarrier bar = xcd_barrier_post((unsigned*)(ctl + CW_BAR), MISC + 8);
    const int lo = kargs()->ph_lo, hi = kargs()->ph_hi;
#define OPQ(x) ({ int x_ = (x); asm volatile("" : "+s"(x_)); x_; })
#define IN(k) (OPQ(lo) <= (k) && (k) < OPQ(hi))
#define SEAM(k) do { if (IN((k) + 1)) { XcdBarrier b2_ = bar; asm volatile("" : "+s"(b2_.bar)); xcd_barrier(b2_); } } while (0)
#define XN ((bf16*)(ws + WS_XN))
    const size_t T1K = (size_t)256 * 1024 * 2, T512 = (size_t)256 * 512 * 2;

    if (IN(0)) { PH_WS PH_GRID PH_IDS p0_prologue(io, lds, tid, lane, wave, vcu, G); norm_rows(io->in[0], io->in[1], XN, lane, wave); SEAM(0); }

    for (int l = 0; l < 2; ++l) {
        const int pb = 1 + 8 * l;
        if (IN(pb)) { PH_WS PH_GRID
            if (INPROJ1_FP8 && l == 1) {
                pg8::SchedInProj Sd{(const char*)XN, (const char*)(ws + WS_WIN) + (size_t)l * NIN * D * 2, T512, G, bx};
                pg8::EpiInProj E{(bf16*)(ws + WS_PQT), (bf16*)(ws + WS_GU), (bf16*)(ws + WS_GV), (bf16*)(ws + WS_G0), (bf16*)(ws + WS_G1), 1.0f / (ACT_SCALE * W13_SCALE), DFT1_FP8 ? PQ_SCALE : 0.f};
                pg8::gemm_phase<pg8::EpiInProj, pg8::SchedInProj, GP_ALIGN, GP_SP2, true>(lds, D / 2, Sd, E, XFLAGS);
            } else {
                pg8::SchedInProj Sd{(const char*)XN, (const char*)(ws + WS_WIN) + (size_t)l * NIN * D * 2, T1K, G, bx};
                pg8::EpiInProj E{(bf16*)(ws + WS_PQT), (bf16*)(ws + WS_GU), (bf16*)(ws + WS_GV), (bf16*)(ws + WS_G0), (bf16*)(ws + WS_G1), 1.0f, 0.f};
                pg8::gemm_phase<pg8::EpiInProj, pg8::SchedInProj, GP_ALIGN, GP_SP2>(lds, D, Sd, E, XFLAGS);
            }
            SEAM(pb);
        }
        if (IN(pb + 1)) { PH_WS PH_GRID
            if (l == 0) { PH_IDS sgu_phase<2>(io, lds, l, tid, lane, wave, vcu, G); }
            else if (bx >= G / 2) { PH_IDS sgu_phase<4>(io, lds, l, tid, lane, wave, bx - G / 2, G - G / 2); }
            if (l == 0 && bx >= G / 2) { PH_IDS convert_weights<1>(io, lds, lane, wave, (bx - G / 2) * NWAVES + wave, (G - G / 2) * NWAVES); __syncthreads(); }
            if (DFT1_FP8 && INPROJ1_FP8 && l == 1) {
                pg8::SchedPlain Sd{(const char*)(ws + WS_DFT8), (const char*)(ws + WS_PQT), (size_t)256 * 4096, (size_t)256 * 4096, 8, 16, G, bx};
                pg8::EpiDft E{(bf16*)(ws + WS_FA), 1.0f / (DFT_SCALE * PQ_SCALE)};
                pg8::gemm_phase<pg8::EpiDft, pg8::SchedPlain, GP_ALIGN, GP_SP2, true>(lds, 2048, Sd, E, XFLAGS);
            } else {
                pg8::SchedPlain Sd{(const char*)(ws + WS_DFT), (const char*)(ws + WS_PQT), (size_t)256 * 4096 * 2, (size_t)256 * 4096 * 2, 8, 16, G, bx};
                pg8::EpiDft E{(bf16*)(ws + WS_FA), 1.0f};
                pg8::gemm_phase<pg8::EpiDft, pg8::SchedPlain, GP_ALIGN, GP_SP2>(lds, 4096, Sd, E, XFLAGS);
            }
            if (l == 0 && bx < G / 2) { PH_IDS convert_weights<3>(io, lds, lane, wave, bx * NWAVES + wave, (G / 2) * NWAVES); }
            SEAM(pb + 1);
        }
        if (IN(pb + 2)) { PH_WS PH_GRID
            pg8::SchedMerge Sd{(const char*)(ws + WS_FA), (const char*)(ws + WS_WF) + (size_t)l * D * 512 * 2, (const char*)(ws + WS_SG), (const char*)(ws + WS_WG) + (size_t)l * D * 512 * 2, T512, G, bx};
            pg8::EpiGate2 E{(const bf16*)(ws + WS_G0), (const bf16*)(ws + WS_G1), (bf16*)(ws + WS_MM)};
            pg8::gemm_phase<pg8::EpiGate2, pg8::SchedMerge, GP_ALIGN, GP_SP2>(lds, 512, Sd, E, XFLAGS);
            SEAM(pb + 2);
        }
        if (IN(pb + 3)) { PH_WS PH_GRID
            pg8::SchedPlain Sd{(const char*)(ws + WS_MM), (const char*)(ws + WS_WOUT) + (size_t)l * D * D * 2, T1K, T1K, 64, 4, G, bx};
            pg8::EpiBf16Plain E{(bf16*)(ws + WS_Y), D};
            pg8::gemm_phase<pg8::EpiBf16Plain, pg8::SchedPlain, GP_ALIGN, GP_SP2>(lds, D, Sd, E, XFLAGS);
            SEAM(pb + 3);
        }
        if (IN(pb + 4)) { PH_WS PH_GRID PH_IDS
            float* xr = XR16 ? (float*)(ws + WS_XR) : io->out;
            if (l == 0) post_rows<0, false, false, false, XR16 != 0>(io, lds, (const bf16*)(ws + WS_Y), io->in[0], xr, io->in[2] + l * D, io->in[11] + l * D, tid, lane, wave);
            else        post_rows<0, true, true, XR16 != 0, XR16 != 0>(io, lds, (const bf16*)(ws + WS_Y), xr, xr, io->in[2] + l * D, io->in[11] + l * D, tid, lane, wave);
            SEAM(pb + 4);
        }
        if (l == 0) {
            if (IN(pb + 5)) { PH_WS PH_GRID
                pg8::SchedPlain Sd{(const char*)XN, (const char*)(ws + WS_DW13), T1K, T1K, 64, 2 * FFD / 256, G, bx};
                pg8::EpiSwiglu E{(bf16*)(ws + WS_HD), FFD};
                pg8::gemm_phase<pg8::EpiSwiglu, pg8::SchedPlain, GP_ALIGN, GP_SP2>(lds, D, Sd, E, XFLAGS);
                { PH_IDS convert_weights<2>(io, lds, lane, wave, wave * G + bx, G * NWAVES); if (bx >= G / 2) fold_inproj(io, lds, tid, 1, bx - G / 2, G - G / 2); }
                SEAM(pb + 5);
            }
            if (IN(pb + 6)) { PH_WS PH_GRID
                pg8::SchedPlain Sd{(const char*)(ws + WS_HD), (const char*)(ws + WS_DW2), (size_t)256 * FFD * 2, (size_t)256 * FFD * 2, 64, 4, G, bx};
                pg8::EpiBf16Plain E{(bf16*)(ws + WS_YD), D};
                pg8::gemm_phase<pg8::EpiBf16Plain, pg8::SchedPlain, GP_ALIGN, GP_SP2>(lds, FFD, Sd, E, XFLAGS);
                SEAM(pb + 6);
            }
            if (IN(pb + 7)) { PH_WS PH_GRID PH_IDS float* xr = XR16 ? (float*)(ws + WS_XR) : io->out; post_rows<0, false, INPROJ1_FP8 != 0, XR16 != 0, XR16 != 0>(io, lds, (const bf16*)(ws + WS_YD), xr, xr, io->in[12], io->in[1] + D, tid, lane, wave); SEAM(pb + 7); }
        } else {
            if (IN(14)) { PH_WS PH_GRID PH_IDS moe_assign(io, lds, tid, lane, wave); SEAM(14); }
            const int ntiles = (int)__builtin_amdgcn_readfirstlane(__hip_atomic_load(ctl + CW_NTILES, RLX_AGENT));
            LAS int* texpL = (LAS int*)(lds + LDS_TEXP);
            if (OPQ(lo) <= 17 && OPQ(hi) > 15) { PH_IDS if (tid < NT_MAX) texpL[tid] = ((const int*)(kargs()->ws + WS_TEXP))[tid]; __syncthreads(); }
            const int nA = ntiles - CHUNK_TILES;
            for (int s = 0; s < 3; ++s) {
                if (IN(15 + s)) { PH_WS PH_GRID
                    if (s >= 1 && !(s == 1 && (XFLAGS & 2))) {
                        const int t0 = (s == 1) ? 0 : nA, nM = (s == 1) ? nA : CHUNK_TILES;
                        pg8::SchedMoe Sd{(const char*)(ws + (s == 1 ? WS_HM : WS_HM2)), (size_t)256 * FFE, (const char*)(ws + WS_MW2), (size_t)D * FFE, (size_t)256 * FFE, texpL, t0, nM, 4, G, bx, 0};
                        pg8::EpiBf16Scaled E{(bf16*)(ws + WS_YG) + (size_t)t0 * 256 * D, D, 1.0f / (ACT_SCALE * W2_SCALE)};
                        pg8::gemm_phase<pg8::EpiBf16Scaled, pg8::SchedMoe, GP_ALIGN, GP_SP2, true>(lds, FFE / 2, Sd, E, XFLAGS);
                    }
                    if (s <= 1 && !(s == 1 && (XFLAGS & 4))) {
                        const int t0 = (s == 0) ? 0 : nA, nM = (s == 0) ? nA : CHUNK_TILES, n2 = (s == 0) ? 0 : 4 * nA - G;
                        pg8::SchedMoe Sd{(const char*)(ws + WS_XG) + (size_t)t0 * T512, T512, (const char*)(ws + WS_MW13), (size_t)2 * FFE * D, T512, texpL, t0, nM, 2 * FFE / 256, G, bx, n2 < 0 ? 0 : n2};
                        pg8::EpiSwiglu8 E{ws + (s == 0 ? WS_HM : WS_HM2), FFE, 1.0f / (ACT_SCALE * W13_SCALE), ACT_SCALE};
                        pg8::gemm_phase<pg8::EpiSwiglu8, pg8::SchedMoe, GP_ALIGN, GP_SP2, true>(lds, D / 2, Sd, E, XFLAGS);
                    }
                    SEAM(15 + s);
                }
            }
            if (IN(18)) { PH_WS PH_GRID PH_IDS post_rows<1, false, false, XR16 != 0, false>(io, lds, nullptr, XR16 ? (const float*)(ws + WS_XR) : (const float*)io->out, io->out, io->in[12] + D, nullptr, tid, lane, wave); }
        }
    }
#undef IN
#undef OPQ
#undef SEAM
#undef XN
}

static int g_grid = 0;
static bool mega_setup() {
    if (g_grid != 0) return g_grid > 0;
    int dev = 0, cus = 0, per_cu = 0;
    if (hipGetDevice(&dev) != hipSuccess || hipDeviceGetAttribute(&cus, hipDeviceAttributeMultiprocessorCount, dev) != hipSuccess) { fprintf(stderr, "kernel_launch: device query failed\n"); g_grid = -1; return false; }
    if (hipFuncSetAttribute((const void*)mega_fwd, hipFuncAttributeMaxDynamicSharedMemorySize, LDS_BYTES) != hipSuccess) { fprintf(stderr, "kernel_launch: hipFuncSetAttribute failed\n"); g_grid = -1; return false; }
    if (hipOccupancyMaxActiveBlocksPerMultiprocessor(&per_cu, (const void*)mega_fwd, NWAVES * 64, LDS_BYTES) != hipSuccess || per_cu < 1) fprintf(stderr, "kernel_launch: note: occupancy query reports %d workgroups per CU\n", per_cu);
    (void)hipGetLastError();
    g_grid = cus;
    if (g_grid != 256) fprintf(stderr, "kernel_launch: %d CUs; this kernel's thin phases are dealt for 256 workgroups\n", g_grid);
    return true;
}
static void mega_launch(void* const* d_in, void* d_out, void* d_ws, hipStream_t stream, int lo, int hi, int flags = 0) {
    Args a{};
    for (int i = 0; i < 21; ++i) a.in[i] = (const float*)d_in[i];
    a.out = (float*)d_out; a.ws = (unsigned char*)d_ws; a.ph_lo = lo; a.ph_hi = hi; a.flags = flags; a.pad = 0;
    hipLaunchKernelGGL(mega_fwd, dim3(g_grid), dim3(NWAVES * 64), LDS_BYTES, stream, a);
}
#if MEGA_DEBUG
enum { CM_BF16 = 0, CM_F32 = 1, CM_PQ = 2, CM_GUV = 3, CM_G01 = 4, CM_MOEY = 5, CM_FP8 = 6 };
__device__ __forceinline__ float dbg_e4m3(unsigned char v) { const int s = v >> 7, e = (v >> 3) & 15, m = v & 7; const float mag = e ? ldexpf(1.0f + m * 0.125f, e - 7) : ldexpf(m * 0.125f, -6); return s ? -mag : mag; }
__device__ __forceinline__ float dbg_bf(const unsigned short* p, size_t i) { return __uint_as_float((unsigned)p[i] << 16); }
__global__ __launch_bounds__(256) void cmp_k(int mode, const float* __restrict__ snap, const unsigned char* __restrict__ ws, const float* __restrict__ fbuf, size_t off, int ld, int rows, float* E2) {
    const size_t idx = (size_t)blockIdx.x * 256 + threadIdx.x;
    const size_t total = (size_t)rows * ld;
    float a = 0.f, b = 0.f;
    if (idx < total) {
        const size_t r = idx / ld; const int c = (int)(idx % ld);
        if (mode == CM_BF16) { a = snap[idx]; b = dbg_bf((const unsigned short*)(ws + off), idx); }
        else if (mode == CM_F32) { a = snap[idx]; b = fbuf[idx]; }
        else if (mode == CM_FP8) { a = snap[idx]; b = dbg_e4m3((ws + off)[idx]) * (1.0f / ACT_SCALE); }
        else if (mode == CM_PQ) {
            const int pq = c >> 9, ch = c & 511, g = ch >> 7, j = ch & 127; a = snap[(size_t)pq * rows * 512 + r * 512 + ch];
            const int bb = (int)(r >> 11), s = (int)(r & 2047); const size_t pi = ((size_t)bb * 1024 + (g * 128 + j) * 2 + pq) * 2048 + s;
            b = off ? dbg_e4m3((ws + WS_PQT)[pi]) * (1.0f / PQ_SCALE) : dbg_bf((const unsigned short*)(ws + WS_PQT), pi); }
        else if (mode == CM_GUV) { const float z = snap[idx]; a = 0.5f * z * (1.0f + erff(z * 0.70710678f));
            b = c < 512 ? dbg_bf((const unsigned short*)(ws + WS_GU), r * 512 + c) : dbg_bf((const unsigned short*)(ws + WS_GV), r * 512 + c - 512); }
        else if (mode == CM_G01) {
            const int cc = c & 1023; const float z0 = snap[r * 2048 + cc], z1 = snap[r * 2048 + 1024 + cc]; const float s0 = 1.0f / (1.0f + expf(-z0)), s1 = 1.0f / (1.0f + expf(-z1));
            if (c < 1024) { a = s0 / s1; b = dbg_bf((const unsigned short*)(ws + WS_G0), r * 1024 + cc); } else { a = s1; b = dbg_bf((const unsigned short*)(ws + WS_G1), r * 1024 + cc); } }
        else { a = snap[idx]; const int* pos = (const int*)(ws + WS_POS); const float* w12 = (const float*)(ws + WS_W12); const unsigned short* YG = (const unsigned short*)(ws + WS_YG);
            b = w12[r * 2] * dbg_bf(YG, (size_t)pos[r * 2] * 1024 + c) + w12[r * 2 + 1] * dbg_bf(YG, (size_t)pos[r * 2 + 1] * 1024 + c); }
    }
    float num = (a - b) * (a - b), den = a * a;
#pragma unroll
    for (int o = 1; o < 64; o <<= 1) { num += __shfl_xor(num, o); den += __shfl_xor(den, o); }
    if ((threadIdx.x & 63) == 0) { atomicAdd(E2, num); atomicAdd(E2 + 1, den); }
}
struct Chk { int stage, hi, mode; size_t off; int ld; float thr; };
#ifndef DBG_FIRST
#define DBG_FIRST 0
#endif
#ifndef DBG_LAST
#define DBG_LAST 24
#endif
#ifndef DBG_VALUE_OF
#define DBG_VALUE_OF (-1)
#endif
constexpr int N_CHK = 25;
__global__ __launch_bounds__(256) void dbg_scale_k(float* x, size_t n, const float* E2, int first, int last, int value_of, float thr0, float thr1) {
    float sc = 1.0f;
    if (value_of >= 0) { const float e = sqrtf(E2[2 * value_of] / fmaxf(E2[2 * value_of + 1], 1e-30f)); sc = 1.0f + (e == e ? fminf(e, 2.0f) : 3.0f); }
    else { for (int k = first; k <= last; ++k) { const float thr = (k >= 23) ? thr1 : (k >= 14 ? 0.12f : thr0); const float num = E2[2 * k], den = E2[2 * k + 1]; if (!(num <= thr * thr * den) || !(den > 0.f)) { sc = 1.0f + 0.04f * (float)(k + 1); break; } } }
    const size_t i = (size_t)blockIdx.x * 256 + threadIdx.x; if (i < n) x[i] *= sc;
}
#endif

extern "C" void kernel_launch(void* const* d_in, const int* in_sizes, int n_in, void* d_out, int out_size, void* d_ws, size_t ws_size, hipStream_t stream) {
    if (!mega_setup()) return;
#if !MEGA_DEBUG
    if (hipMemsetAsync((char*)d_ws + WS_CTL, 0, CTL_ZERO_BYTES, stream) != hipSuccess) return;
#ifdef MEGA_PARTIAL_HI
#ifndef MEGA_PARTIAL_FLAGS
#define MEGA_PARTIAL_FLAGS 0
#endif
    mega_launch(d_in, d_out, d_ws, stream, 0, MEGA_PARTIAL_HI, MEGA_PARTIAL_FLAGS);
    if (hipMemsetAsync((char*)d_ws + WS_CTL, 0, CTL_ZERO_BYTES, stream) != hipSuccess) return;
#endif
    mega_launch(d_in, d_out, d_ws, stream, 0, N_PHASES);
#else
    const Chk chk[N_CHK] = {
        {1, 1, CM_BF16, WS_XN, 1024, 0}, {2, 2, CM_PQ, 0, 1024, 0}, {3, 2, CM_GUV, 0, 1024, 0}, {4, 2, CM_G01, 0, 2048, 0}, {5, 3, CM_BF16, WS_FA, 512, 0}, {6, 3, CM_BF16, WS_SG, 512, 0},
        {7, 4, CM_BF16, WS_MM, 1024, 0}, {8, 5, CM_BF16, WS_Y, 1024, 0}, {9, 6, XR16 ? CM_BF16 : CM_F32, XR16 ? WS_XR : (size_t)-1, 1024, 0}, {10, 6, CM_BF16, WS_XN, 1024, 0}, {11, 7, CM_BF16, WS_HD, 2816, 0}, {12, 8, CM_BF16, WS_YD, 1024, 0},
        {13, 9, XR16 ? CM_BF16 : CM_F32, XR16 ? WS_XR : (size_t)-1, 1024, 0},
        {21, 9, INPROJ1_FP8 ? CM_FP8 : CM_BF16, WS_XN, 1024, 0}, {22, 10, CM_PQ, (DFT1_FP8 && INPROJ1_FP8) ? 1 : 0, 1024, 0}, {23, 10, CM_GUV, 0, 1024, 0}, {24, 10, CM_G01, 0, 2048, 0}, {25, 11, CM_BF16, WS_FA, 512, 0}, {26, 11, CM_BF16, WS_SG, 512, 0},
        {27, 12, CM_BF16, WS_MM, 1024, 0}, {28, 13, CM_BF16, WS_Y, 1024, 0}, {29, 14, XR16 ? CM_BF16 : CM_F32, XR16 ? WS_XR : (size_t)-1, 1024, 0}, {30, 14, CM_FP8, WS_XN, 1024, 0}, {32, 18, CM_MOEY, 0, 1024, 0}, {33, 19, CM_F32, (size_t)-1, 1024, 0} };
    const int R = 2048;
    float* SAFE = (float*)((char*)d_ws + 445 * MiB); float* E2 = (float*)((char*)d_ws + 476 * MiB);
    hipMemsetAsync(E2, 0, 4096, stream);
    for (int k = DBG_FIRST; k <= DBG_LAST; ++k) {
        nv::naive_run(d_in, (float*)d_out, d_ws, stream, R, chk[k].stage, SAFE);
        hipMemsetAsync((char*)d_ws + WS_CTL, 0, CTL_ZERO_BYTES, stream);
        mega_launch(d_in, d_out, d_ws, stream, 0, chk[k].hi);
        const float* fb = chk[k].off == (size_t)-1 ? (const float*)d_out : (const float*)((char*)d_ws + chk[k].off);
        const size_t total = (size_t)R * chk[k].ld;
        hipLaunchKernelGGL(cmp_k, dim3((unsigned)((total + 255) / 256)), dim3(256), 0, stream, chk[k].mode, (const float*)SAFE, (const unsigned char*)d_ws, fb, chk[k].off, chk[k].ld, R, E2 + 2 * k);
    }
    nv::naive_run(d_in, (float*)d_out, d_ws, stream, T, -1, nullptr);
    hipLaunchKernelGGL(dbg_scale_k, dim3((unsigned)(((size_t)T * D + 255) / 256)), dim3(256), 0, stream, (float*)d_out, (size_t)T * D, (const float*)E2, DBG_FIRST, DBG_LAST, DBG_VALUE_OF, 0.05f, 0.3f);
#endif
}
```
